# Optimizing an MI355X kernel written in HIP

```python
import jax, jax.numpy as jnp
from jax import lax
import numpy as np

D_MODEL = 1024
BATCH = 8
SEQ = 2048
DEPTH = 2

GRID_W = 64
CTX_LEN = 256
N_MIXERS = 2
POOL_WINDOWS = (2, 4, 8, 16)
N_POOL_GROUPS = 4
POOL_GROUP = D_MODEL // N_POOL_GROUPS
N_HEADS = D_MODEL // 128
Q_LORA = D_MODEL // 2
KV_LORA = D_MODEL // 4
QK_NOPE = 128
QK_ROPE = 64
V_HEAD = 128
ROPE_AXIS = QK_ROPE // 2
ROPE_BASE = 10000.0
ATTN_SCALE = (QK_NOPE + QK_ROPE) ** -0.5
Q_BLOCK = 128
N_EXPERTS = 32
TOP_K = 4
D_FF = D_MODEL
SWIGLU_LIMIT = 7.0
SWIGLU_ALPHA = 1.702
EXPERT_BLOCK = 256
EPS = 1e-6
N_POOL_LAYERS = (DEPTH + 1) // 2
N_MLA_LAYERS = DEPTH // 2

kernel_name = "hybrid_pool_mla_moe_prefix_trunk"


def rmsnorm(x, g):
    xf = x.astype(jnp.float32)
    y = xf * lax.rsqrt(jnp.mean(xf * xf, axis=-1, keepdims=True) + EPS)
    return (y * g.astype(jnp.float32)).astype(x.dtype)


def modulate(h, shift, scale):
    return h * (1 + scale) + shift


def centred_mean(h, w):
    L = h.shape[1]
    cs = jnp.cumsum(h.astype(jnp.float32), axis=1)
    cs = jnp.pad(cs, ((0, 0), (1, 0), (0, 0)))
    t = jnp.arange(L)
    lo = jnp.clip(t - w // 2, 0, L)
    hi = jnp.clip(t + w - w // 2, 0, L)
    s = cs[:, hi] - cs[:, lo]
    cnt = (hi - lo).astype(jnp.float32)
    return (s / cnt[None, :, None]).astype(h.dtype)


def pool_mixer(h, w, b, scale):
    B, L, D = h.shape
    hg = h.reshape(B, L, N_POOL_GROUPS, POOL_GROUP)
    d = jnp.stack([centred_mean(hg[:, :, g], POOL_WINDOWS[g]) - hg[:, :, g]
                   for g in range(N_POOL_GROUPS)], axis=2)
    y = jnp.einsum('blgc,gcd->blgd', d, w).reshape(B, L, D) + b
    return y * scale


def rotate(x, ang):
    x1, x2 = jnp.split(x, 2, axis=-1)
    cos = jnp.cos(ang)[None, :, None, :].astype(x.dtype)
    sin = jnp.sin(ang)[None, :, None, :].astype(x.dtype)
    return jnp.concatenate([x1 * cos - x2 * sin, x2 * cos + x1 * sin], axis=-1)


def axial_rope(x, ang_row, ang_col):
    xr, xc = jnp.split(x, 2, axis=-1)
    return jnp.concatenate([rotate(xr, ang_row), rotate(xc, ang_col)], axis=-1)


def mla_q(h, w_dq, q_norm_g, w_uq, ang):
    B, L, _ = h.shape
    q = (rmsnorm(h @ w_dq, q_norm_g) @ w_uq).reshape(B, L, N_HEADS, QK_NOPE + QK_ROPE)
    q_nope, q_pe = q[..., :QK_NOPE], q[..., QK_NOPE:]
    if ang is not None:
        q_pe = axial_rope(q_pe, *ang)
    return jnp.concatenate([q_nope, q_pe], axis=-1)


def mla_kv(h, w_dkv, kv_norm_g, w_ukv, ang):
    B, L, _ = h.shape
    kv_a = h @ w_dkv
    c_kv, k_pe = kv_a[..., :KV_LORA], kv_a[..., KV_LORA:][:, :, None, :]
    kv = (rmsnorm(c_kv, kv_norm_g) @ w_ukv).reshape(B, L, N_HEADS, QK_NOPE + V_HEAD)
    k_nope, v = kv[..., :QK_NOPE], kv[..., QK_NOPE:]
    if ang is not None:
        k_pe = axial_rope(k_pe, *ang)
    k = jnp.concatenate([k_nope, jnp.broadcast_to(k_pe, (B, L, N_HEADS, QK_ROPE))], axis=-1)
    return k, v


def attend(q, k, v):
    s = jnp.einsum('bqhd,bkhd->bhqk', q, k).astype(jnp.float32) * ATTN_SCALE
    p = jax.nn.softmax(s, axis=-1).astype(v.dtype)
    return jnp.einsum('bhqk,bkhd->bqhd', p, v)


def blocked_attention(q, k, v):
    B, L, H, Dk = q.shape
    nb = L // Q_BLOCK
    qb = jnp.moveaxis(q.reshape(B, nb, Q_BLOCK, H, Dk), 1, 0)
    ob = lax.map(lambda qq: attend(qq, k, v), qb)
    return jnp.moveaxis(ob, 0, 1).reshape(B, L, H * V_HEAD)


def moe_ffn(h, router_w, router_b, w_gu, b_gu, w_down, b_down):
    T, D = h.shape
    logits = (h @ router_w + router_b).astype(jnp.float32)
    top_logits, top_e = lax.top_k(logits, TOP_K)
    gates = jax.nn.softmax(top_logits, axis=-1).astype(h.dtype)
    n_assign = T * TOP_K
    flat_e = top_e.reshape(-1)
    order = jnp.argsort(flat_e)
    sorted_e = flat_e[order]
    counts = jnp.bincount(flat_e, length=N_EXPERTS)
    padded = (counts + EXPERT_BLOCK - 1) // EXPERT_BLOCK * EXPERT_BLOCK
    start = jnp.cumsum(counts) - counts
    pends = jnp.cumsum(padded)
    pstart = pends - padded
    slot = (pstart[sorted_e] + jnp.arange(n_assign) - start[sorted_e]).astype(jnp.int32)
    n_blocks = -(-n_assign // EXPERT_BLOCK) + N_EXPERTS
    n_slots = n_blocks * EXPERT_BLOCK
    slot_token = jnp.full((n_slots,), T, jnp.int32).at[slot].set((order // TOP_K).astype(jnp.int32))
    block_expert = jnp.clip(jnp.searchsorted(pends, jnp.arange(n_blocks) * EXPERT_BLOCK, side='right'),
                            0, N_EXPERTS - 1)
    h_pad = jnp.concatenate([h, jnp.zeros((1, D), h.dtype)], axis=0)
    xs = h_pad[slot_token].reshape(n_blocks, EXPERT_BLOCK, D)

    def expert_block(args):
        xb, e = args
        gu = xb @ w_gu[e] + b_gu[e]
        gate = jnp.minimum(gu[:, :D_FF], SWIGLU_LIMIT)
        up = jnp.clip(gu[:, D_FF:], -SWIGLU_LIMIT, SWIGLU_LIMIT)
        act = (up + 1) * (gate * jax.nn.sigmoid(SWIGLU_ALPHA * gate))
        return act @ w_down[e] + b_down[e]

    ys = lax.map(expert_block, (xs, block_expert)).reshape(n_slots, D)
    assign_slot = jnp.zeros((n_assign,), jnp.int32).at[order].set(slot)
    y = ys[assign_slot].reshape(T, TOP_K, D)
    return jnp.einsum('tk,tkd->td', gates, y)


def setup_inputs(seed: int = 0) -> dict:
    key = jax.random.key(seed)
    ks = jax.random.split(key, 32)
    D, f32 = D_MODEL, jnp.float32
    nrm = lambda k, shape, s: jax.random.normal(k, shape, f32) * s
    gain = lambda k, shape: 1.0 + 0.02 * jax.random.normal(k, shape, f32)
    return {
        "x": nrm(ks[0], (BATCH, SEQ, D), 1.0),
        "c": nrm(ks[1], (BATCH, D), 1.0),
        "ctx": nrm(ks[2], (BATCH, CTX_LEN, D), 1.0),
        "c_ctx": nrm(ks[3], (D,), 1.0),
        "ada_w": nrm(ks[4], (DEPTH, D, 6 * D), 0.5 * D ** -0.5),
        "ada_b": nrm(ks[5], (DEPTH, 6 * D), 0.02),
        "norm1_g": gain(ks[6], (DEPTH, D)),
        "norm2_g": gain(ks[7], (DEPTH, D)),
        "pool_w": nrm(ks[8], (N_POOL_LAYERS, N_POOL_GROUPS, POOL_GROUP, POOL_GROUP), POOL_GROUP ** -0.5),
        "pool_b": nrm(ks[9], (N_POOL_LAYERS, D), 0.02),
        "pool_scale": gain(ks[10], (N_POOL_LAYERS, D)),
        "w_dq": nrm(ks[11], (N_MLA_LAYERS, D, Q_LORA), D ** -0.5),
        "q_norm_g": gain(ks[12], (N_MLA_LAYERS, Q_LORA)),
        "w_uq": nrm(ks[13], (N_MLA_LAYERS, Q_LORA, N_HEADS * (QK_NOPE + QK_ROPE)), Q_LORA ** -0.5),
        "w_dkv": nrm(ks[14], (N_MLA_LAYERS, D, KV_LORA + QK_ROPE), D ** -0.5),
        "kv_norm_g": gain(ks[15], (N_MLA_LAYERS, KV_LORA)),
        "w_ukv": nrm(ks[16], (N_MLA_LAYERS, KV_LORA, N_HEADS * (QK_NOPE + V_HEAD)), KV_LORA ** -0.5),
        "w_o": nrm(ks[17], (N_MLA_LAYERS, N_HEADS * V_HEAD, D), (N_HEADS * V_HEAD) ** -0.5),
        "router_w": nrm(ks[18], (DEPTH, D, N_EXPERTS), D ** -0.5),
        "router_b": nrm(ks[19], (DEPTH, N_EXPERTS), 0.01),
        "w_gu": nrm(ks[20], (DEPTH, N_EXPERTS, D, 2 * D_FF), D ** -0.5),
        "b_gu": nrm(ks[21], (DEPTH, N_EXPERTS, 2 * D_FF), 0.02),
        "w_down": nrm(ks[22], (DEPTH, N_EXPERTS, D_FF, D), D_FF ** -0.5),
        "b_down": nrm(ks[23], (DEPTH, N_EXPERTS, D), 0.02),
        "final_g": gain(ks[24], (D,)),
    }


def reference(x, c, ctx, c_ctx, ada_w, ada_b, norm1_g, norm2_g, pool_w, pool_b, pool_scale,
              w_dq, q_norm_g, w_uq, w_dkv, kv_norm_g, w_ukv, w_o,
              router_w, router_b, w_gu, b_gu, w_down, b_down, final_g):
    B, L, D = x.shape
    C = ctx.shape[1]
    rows = L // GRID_W
    row_pos = jnp.repeat(jnp.arange(rows), GRID_W).astype(jnp.float32)
    col_pos = jnp.tile(jnp.arange(GRID_W), rows).astype(jnp.float32)
    inv_freq = ROPE_BASE ** (-jnp.arange(0, ROPE_AXIS, 2, dtype=jnp.float32) / ROPE_AXIS)
    ang = (row_pos[:, None] * inv_freq, col_pos[:, None] * inv_freq)

    xc = ctx
    sc_lat = jax.nn.silu(c)
    sc_ctx = jax.nn.silu(c_ctx)
    for i in range(DEPTH):
        is_last = i == DEPTH - 1
        mixer = i % N_MIXERS
        j = i // N_MIXERS
        mod = sc_lat @ ada_w[i] + ada_b[i]
        sh1, s1, g1, sh2, s2, g2 = jnp.split(mod[:, None, :], 6, axis=-1)
        ctx_needed = (not is_last) or mixer == 1
        if ctx_needed:
            modc = sc_ctx @ ada_w[i] + ada_b[i]
            sh1c, s1c, g1c, sh2c, s2c, g2c = jnp.split(modc, 6, axis=-1)
            hc = modulate(rmsnorm(xc, norm1_g[i]), sh1c, s1c)
        h = modulate(rmsnorm(x, norm1_g[i]), sh1, s1)

        if mixer == 0:
            x = x + g1 * pool_mixer(h, pool_w[j], pool_b[j], pool_scale[j])
            if not is_last:
                xc = xc + g1c * pool_mixer(hc, pool_w[j], pool_b[j], pool_scale[j])
        else:
            kc, vc = mla_kv(hc, w_dkv[j], kv_norm_g[j], w_ukv[j], None)
            kl, vl = mla_kv(h, w_dkv[j], kv_norm_g[j], w_ukv[j], ang)
            ql = mla_q(h, w_dq[j], q_norm_g[j], w_uq[j], ang)
            k_all = jnp.concatenate([kc, kl], axis=1)
            v_all = jnp.concatenate([vc, vl], axis=1)
            x = x + g1 * (blocked_attention(ql, k_all, v_all) @ w_o[j])
            if not is_last:
                qc = mla_q(hc, w_dq[j], q_norm_g[j], w_uq[j], None)
                yc = attend(qc, kc, vc).reshape(B, C, N_HEADS * V_HEAD)
                xc = xc + g1c * (yc @ w_o[j])

        h2 = modulate(rmsnorm(x, norm2_g[i]), sh2, s2)
        if is_last:
            y = moe_ffn(h2.reshape(B * L, D), router_w[i], router_b[i], w_gu[i], b_gu[i],
                        w_down[i], b_down[i])
            x = x + g2 * y.reshape(B, L, D)
        else:
            h2c = modulate(rmsnorm(xc, norm2_g[i]), sh2c, s2c)
            tokens = jnp.concatenate([h2.reshape(B * L, D), h2c.reshape(B * C, D)], axis=0)
            y = moe_ffn(tokens, router_w[i], router_b[i], w_gu[i], b_gu[i], w_down[i], b_down[i])
            x = x + g2 * y[:B * L].reshape(B, L, D)
            xc = xc + g2c * y[B * L:].reshape(B, C, D)

    return rmsnorm(x, final_g)
```

```cpp
#include <hip/hip_runtime.h>
#include <cstdio>
#include <cstdint>

#ifndef MK_PER_PHASE
#define MK_PER_PHASE 0
#endif

#ifndef REP_MASK
#define REP_MASK 0u
#endif
#ifndef PROBE_ATT
#define PROBE_ATT 0
#endif
#ifndef PROBE_NOEPI
#define PROBE_NOEPI 0
#endif
__device__ __forceinline__ int rep_bound(int v) { if (REP_MASK != 0u) asm volatile("" : "+s"(v)); return v; }
#define REPEAT(k) _Pragma("nounroll") for (int rep_ = 0, repn_ = rep_bound((int)((REP_MASK >> (k)) & 1u)); rep_ <= repn_; ++rep_) if (rep_ > 0 ? (__syncthreads(), true) : true)
#define LAS __attribute__((address_space(3)))
typedef unsigned short bf16_t;
typedef short bf16x8 __attribute__((ext_vector_type(8)));
typedef short s16x4 __attribute__((ext_vector_type(4)));
typedef float f32x4 __attribute__((ext_vector_type(4)));
typedef float f32x2 __attribute__((ext_vector_type(2)));
typedef float f32x16 __attribute__((ext_vector_type(16)));
typedef unsigned u32x4 __attribute__((ext_vector_type(4)));
typedef unsigned u32x2 __attribute__((ext_vector_type(2)));

constexpr int D = 1024, NB = 8, SEQ = 2048, CTXL = 256;
constexpr int NL = NB * SEQ, NC = NB * CTXL, NT = NL + NC;
constexpr int NE = 32, TOPK = 4;
constexpr int NH = 8, QLORA = 512, KVLORA = 256, DNOPE = 128, DROPE = 64, DV = 128, DQK = 192, SKV = CTXL + SEQ;
constexpr float EPS = 1e-6f;
constexpr int MAXSLOT0 = NT * TOPK + NE * 256;
constexpr int NWAVES = 8, NTHR = 512, GRID = 256;

constexpr size_t MiB = 1u << 20;
constexpr size_t WS_CTL = 0, CTL_ZERO_BYTES = 64 * 1024;
constexpr size_t WS_MODV = 1 * MiB;
constexpr size_t WS_ROPE = WS_MODV + 512 * 1024;
constexpr size_t WS_RWT = WS_ROPE + 64 * 1024;
constexpr size_t WS_SSQ = 2 * MiB;
constexpr size_t WS_ROUTE = 3 * MiB;
constexpr size_t WS_BLKCNT = WS_ROUTE + 3 * (size_t)NT * 4 * 4;
constexpr size_t WS_SLOTAID = 1326 * MiB;
constexpr size_t WS_SLOTTOK = 1330 * MiB;
constexpr size_t WS_WPOOL = 5 * MiB, WS_WP1 = 6 * MiB, WS_WUQ = 8 * MiB, WS_WUKV = 10 * MiB, WS_WO = 12 * MiB;
constexpr size_t WS_WGU = 16 * MiB;
constexpr size_t WS_WDN = 272 * MiB;
constexpr size_t WS_H8 = 1306 * MiB;
constexpr size_t WS_X1 = 400 * MiB, WS_X2 = 472 * MiB, WS_X3 = 544 * MiB;
constexpr size_t WS_H = 608 * MiB;
constexpr size_t WS_XS = 644 * MiB, WS_ACT = 804 * MiB, WS_YS = 964 * MiB;
constexpr size_t WS_QA = 1108 * MiB, WS_CKV = 1126 * MiB, WS_Q = 1136 * MiB, WS_K = 1184 * MiB, WS_V = 1238 * MiB, WS_ATT = 1274 * MiB;
constexpr size_t WS_END = 1334 * MiB;
constexpr int CW_BAR = 1024;
constexpr int CW_GCOUNT = 8192;

constexpr int RING_BYTES = 131072;
constexpr int MISC_OFF = 154624;
constexpr int LDS_BYTES = 163840;
constexpr int M_BAR = 0, M_TAB = 64, M_TSTART = 640, M_GCNT = 896, M_LCNT = 1024, M_LBASE = 1152, M_RINV = 8192;
constexpr int TOK_OFF = 131072;
constexpr int BIAS_OFF = TOK_OFF + 10240;

__device__ __forceinline__ unsigned f2bf(float f) { unsigned u = __builtin_bit_cast(unsigned, f); return (u + 0x7fffu + ((u >> 16) & 1u)) >> 16; }
__device__ __forceinline__ unsigned pk2(float lo, float hi) { return f2bf(lo) | (f2bf(hi) << 16); }
__device__ __forceinline__ unsigned cvt_pk_bf16(float lo, float hi) { unsigned r; asm volatile("v_cvt_pk_bf16_f32 %0, %1, %2" : "=v"(r) : "v"(lo), "v"(hi)); return r; }
__device__ __forceinline__ float bf_lo(unsigned w) { return __builtin_bit_cast(float, w << 16); }
__device__ __forceinline__ float bf_hi(unsigned w) { return __builtin_bit_cast(float, w & 0xffff0000u); }
__device__ __forceinline__ float wave_sum(float v) {
#pragma unroll
    for (int o = 1; o < 64; o <<= 1) v += __shfl_xor(v, o);
    return v;
}
__device__ __forceinline__ int opq(int v) { asm volatile("" : "+v"(v)); return v; }
__device__ __forceinline__ int lane_id() { int v; asm volatile("v_mbcnt_lo_u32_b32 %0, -1, 0\n\tv_mbcnt_hi_u32_b32 %0, -1, %0" : "=v"(v)); return v; }
__device__ __forceinline__ float clamp8(float v) { return fminf(fmaxf(v, -448.f), 448.f); }
__device__ __forceinline__ unsigned pk_fp8x4(f32x4 v) { int p = __builtin_amdgcn_cvt_pk_fp8_f32(clamp8(v.x), clamp8(v.y), 0, false); p = __builtin_amdgcn_cvt_pk_fp8_f32(clamp8(v.z), clamp8(v.w), p, true); return (unsigned)p; }
__device__ __forceinline__ const char* uni_ptr(const char* p) { const unsigned long long x = (unsigned long long)p; const unsigned lo = __builtin_amdgcn_readfirstlane((unsigned)x), hi = __builtin_amdgcn_readfirstlane((unsigned)(x >> 32)); return (const char*)(((unsigned long long)hi << 32) | lo); }
#ifndef WT_STORES
#define WT_STORES 0
#endif
__device__ __forceinline__ void gst16(void* p, u32x4 v) {
#if WT_STORES
    asm volatile("global_store_dwordx4 %0, %1, off sc1" :: "v"(p), "v"(v) : "memory");
#else
    *(u32x4*)p = v;
#endif
}
__device__ __forceinline__ void gst16(void* p, f32x4 v) { gst16(p, __builtin_bit_cast(u32x4, v)); }
__device__ __forceinline__ u32x2 pk_fp8x8(f32x4 a, f32x4 b, float sc) { u32x2 r; r.x = pk_fp8x4(a * sc); r.y = pk_fp8x4(b * sc); return r; }
__device__ __forceinline__ void unpk8(u32x4 w, f32x4& a, f32x4& b) { a = (f32x4){bf_lo(w.x), bf_hi(w.x), bf_lo(w.y), bf_hi(w.y)}; b = (f32x4){bf_lo(w.z), bf_hi(w.z), bf_lo(w.w), bf_hi(w.w)}; }
__device__ __forceinline__ u32x4 pk8(f32x4 a, f32x4 b) { u32x4 w; w.x = pk2(a.x, a.y); w.y = pk2(a.z, a.w); w.z = pk2(b.x, b.y); w.w = pk2(b.z, b.w); return w; }
#define LDS_WAIT() asm volatile("s_waitcnt lgkmcnt(0)" ::: "memory")
#define VM_WAIT() asm volatile("s_waitcnt vmcnt(0)" ::: "memory")

#define XB_TMO      128
#define XB_XCNT(j)  (256  + 64 * (j))
#define XB_XSUB(j)  (1280 + 64 * (j))
#define XB_XGEN(j)  (2304 + 64 * (j))
#define XB_TOP      3328
#define XB_TOPGEN   3392
#define XCD_BAR_WORDS 3456
#define XB_SPIN_CAP (1u << 18)
__device__ __forceinline__ unsigned xb_ld(unsigned* p)              { return __hip_atomic_load(p, __ATOMIC_RELAXED, __HIP_MEMORY_SCOPE_AGENT); }
__device__ __forceinline__ unsigned xb_add(unsigned* p, unsigned v) { return __hip_atomic_fetch_add(p, v, __ATOMIC_RELAXED, __HIP_MEMORY_SCOPE_AGENT); }
__device__ __forceinline__ unsigned xb_xcc_id() { return (unsigned)__builtin_amdgcn_s_getreg((3 << 11) | 20) & 0xFu; }
#define XB_SPIN(cond, bar) do { unsigned _sp = 0; while (cond) { __builtin_amdgcn_s_sleep(1); \
    if ((++_sp & 255u) == 0u) { if (xb_ld(&(bar)[XB_TMO])) break; if (_sp > XB_SPIN_CAP) { atomicAdd(&(bar)[XB_TMO], 1u); break; } } } } while (0)
struct XcdBarrier { unsigned* bar; unsigned x; volatile LAS unsigned* st; };
__device__ __forceinline__ XcdBarrier xcd_barrier_post(unsigned* bar, volatile LAS unsigned* st) {
    XcdBarrier b; b.bar = bar; b.x = xb_xcc_id(); b.st = st;
    if (threadIdx.x == 0) (void)xb_add(&bar[XB_XCNT(b.x)], 1u);
    return b;
}
__device__ __forceinline__ void xcd_barrier_complete(unsigned* bar, unsigned x, unsigned& nloc, unsigned& nx) {
    const unsigned G = gridDim.x * gridDim.y * gridDim.z;
    unsigned sum, cnt, mine, sp = 0u;
    for (;;) {
        sum = 0u; cnt = 0u; mine = 0u;
#pragma unroll
        for (unsigned j = 0; j < 16; ++j) { const unsigned c = xb_ld(&bar[XB_XCNT(j)]); sum += c; cnt += (c > 0u) ? 1u : 0u; mine = (j == x) ? c : mine; }
        if (sum == G) break;
        __builtin_amdgcn_s_sleep(1);
        if ((++sp & 255u) == 0u) { if (xb_ld(&bar[XB_TMO])) break; if (sp > XB_SPIN_CAP) { atomicAdd(&bar[XB_TMO], 1u); break; } }
    }
    nloc = mine > 0u ? mine : 1u; nx = cnt > 0u ? cnt : 1u;
}
__device__ __forceinline__ void xcd_barrier(const XcdBarrier& b, bool leader) {
    asm volatile("s_waitcnt vmcnt(0)" ::: "memory");
    __syncthreads();
    if (leader) {
        unsigned* bar = b.bar;
        __builtin_amdgcn_s_waitcnt(0);
        unsigned nloc = b.st[0], nx = b.st[1];
        if (nloc == 0u) { xcd_barrier_complete(bar, b.x, nloc, nx); b.st[0] = nloc; b.st[1] = nx; }
        const unsigned old = xb_add(&bar[XB_XSUB(b.x)], 1u);
        const unsigned gen = old / nloc;
        if (old + 1u == (gen + 1u) * nloc) {
            __builtin_amdgcn_fence(__ATOMIC_RELEASE, "agent");
            asm volatile("s_waitcnt vmcnt(0)" ::: "memory");
            const unsigned og = xb_add(&bar[XB_TOP], 1u);
            const unsigned tg = og / nx;
            if (og + 1u == (tg + 1u) * nx) xb_add(&bar[XB_TOPGEN], 1u);
            else XB_SPIN(xb_ld(&bar[XB_TOPGEN]) == tg, bar);
            __builtin_amdgcn_fence(__ATOMIC_ACQUIRE, "agent");
            xb_add(&bar[XB_XGEN(b.x)], 1u);
            asm volatile("s_waitcnt vmcnt(0)" ::: "memory");
        } else {
            XB_SPIN(xb_ld(&bar[XB_XGEN(b.x)]) == gen, bar);
            __builtin_amdgcn_fence(__ATOMIC_ACQUIRE, "agent");
            asm volatile("s_waitcnt vmcnt(0)" ::: "memory");
        }
    }
    __syncthreads();
}

namespace pg8 {
constexpr int BM = 256, BK = 64, HALF = 128, HTB = HALF * BK * 2, STAGE_BYTES = 8 * HTB;
__host__ __device__ __forceinline__ int lds_byte(int r, int c) { const int st = (r >> 4) * 2 + (c >> 5), rr = r & 15, cc = c & 31, ob = rr * 64 + cc * 2; return st * 1024 + (ob ^ (((ob >> 9) & 1) << 5)); }
__host__ __device__ __forceinline__ void stage_rc(int b, int& R, int& C) { const int st = b / 1024, sb = b % 1024, swz = sb ^ (((sb >> 9) & 1) << 5); R = (st >> 1) * 16 + swz / 64; C = (st & 1) * 32 + (swz % 64) / 2; }
__host__ __device__ __forceinline__ int perm32(int rho) { const int n = rho >> 4, i = rho & 15; return 8 * (i >> 2) + 4 * n + (i & 3); }

struct Unit { int pm, pn, e, mt, nv, nt; const char* A; const char* B; };
struct GemmP { int ldaB, ldbB, nt; };
typedef int i32x4 __attribute__((ext_vector_type(4)));
typedef int i32x8 __attribute__((ext_vector_type(8)));
typedef float f32x8 __attribute__((ext_vector_type(8)));
__device__ __forceinline__ i32x8 cat8(bf16x8 a, bf16x8 b) { return __builtin_shufflevector(__builtin_bit_cast(i32x4, a), __builtin_bit_cast(i32x4, b), 0, 1, 2, 3, 4, 5, 6, 7); }

__device__ __forceinline__ int xcd_remap(int L, int nwg) { const int q = nwg / 8, r = nwg % 8, xcd = L % 8, off = L / 8; return (xcd < r ? xcd * (q + 1) : r * (q + 1) + (xcd - r) * q) + off; }

struct PlainSched {
    int nM, nN, nwg, G, c; const char* Ab; const char* Bb; size_t a_t, a_n, b_t;
    __device__ __forceinline__ bool next(int i, Unit& u) const {
        const int L = i * G + c; if (L >= nwg) return false;
        const int wgid = xcd_remap(L, nwg);
        const int nig = 8 * nN, gid = wgid / nig, fm = gid * 8, gsz = (nM - fm) < 8 ? (nM - fm) : 8;
        u.pm = fm + ((wgid % nig) % gsz); u.pn = (wgid % nig) / gsz; u.e = 0; u.mt = 0; u.nv = 256; u.nt = 0;
        u.A = Ab + (size_t)u.pm * a_t + (size_t)u.pn * a_n; u.B = Bb + (size_t)u.pn * b_t; return true;
    }
};
struct MoeSched {
    const LAS int* tab; int n; const char* Ab; const char* Bb; size_t a_t, b_e, b_t;
    __device__ __forceinline__ bool next(int i, Unit& u) const {
        if (i >= n) return false;
        u.pm = __builtin_amdgcn_readfirstlane(tab[8 * i]); u.pn = __builtin_amdgcn_readfirstlane(tab[8 * i + 1]); u.e = __builtin_amdgcn_readfirstlane(tab[8 * i + 2]);
        u.mt = __builtin_amdgcn_readfirstlane(tab[8 * i + 3]); u.nv = __builtin_amdgcn_readfirstlane(tab[8 * i + 4]); u.nt = i;
        u.A = Ab + (size_t)u.pm * a_t; u.B = Bb + (size_t)u.e * b_e + (size_t)u.pn * b_t; return true;
    }
};

template <bool FP8, bool GATHER, bool VARK, class Epi, class Sched>
__device__ __forceinline__ void gemm_phase(LAS unsigned char* lds, const GemmP g, const Sched& S, const Epi& E, int wave_s, bool skip_epi = false) {
    const int lane = opq(lane_id()), wid = wave_s, tid = wid * 64 + lane, wr = wid >> 2, wc = wid & 3, fr = lane & 15, fq = lane >> 4;
    int RA, RB, C2; { int R, C; stage_rc(tid * 16, R, C); RA = R; RB = Epi::PERM ? ((R & ~31) + perm32(R & 31)) : R; C2 = C * 2; }
    const LAS int* tokl = (const LAS int*)(lds + TOK_OFF); unsigned gof[2][2] = {{0u, 0u}, {0u, 0u}};
#define PG8_TOKOFF(ui_, h_, q_) ((unsigned)tokl[(ui_) * 256 + (h_) * 128 + (q_) * 64 + RA] * (unsigned)g.ldaB + (unsigned)C2)
    const size_t kstep = (size_t)(BK * 2);
    const unsigned ldsw = (unsigned)wid * 1024u;
    const int aoff = lds_byte(wr * 64 + fr, fq * 8), boff = lds_byte(wc * 32 + fr, fq * 8);
#define PG8_SA(b, h) (((b) * 2 + (h)) * HTB)
#define PG8_SB(b, h) ((4 + (b) * 2 + (h)) * HTB)
#define PG8_STAGE_X(bufoff, gbase, Rrow_, ld_) do { const unsigned vo_ = (unsigned)(Rrow_) * (unsigned)(ld_) + (unsigned)C2; _Pragma("unroll") for (int _i = 0; _i < 2; ++_i) { \
        const char* gb_ = uni_ptr((const char*)(gbase) + (size_t)_i * 64 * (ld_)); asm volatile("" : "+s"(gb_)); \
        __builtin_amdgcn_global_load_lds((const unsigned*)(gb_ + vo_), (LAS unsigned*)(lds + (bufoff) + ldsw + _i * 8192), 16, 0, 0); } } while (0)
#define PG8_STAGE_B(bufoff, bbase, h_, ld_) PG8_STAGE_X(bufoff, (bbase) + (size_t)(h_) * 128 * (ld_), RB, ld_)
#define PG8_STAGE_A(bufoff, abase, h_, ld_) do { if constexpr (GATHER) { _Pragma("unroll") for (int _i = 0; _i < 2; ++_i) { const char* gb_ = (const char*)(abase); asm volatile("" : "+s"(gb_)); \
        __builtin_amdgcn_global_load_lds((const unsigned*)(gb_ + gof[h_][_i]), (LAS unsigned*)(lds + (bufoff) + ldsw + _i * 8192), 16, 0, 0); } } \
        else { PG8_STAGE_X(bufoff, (abase) + (size_t)(h_) * 128 * (ld_), RA, ld_); } } while (0)
#define PG8_LDA(dst, b, h) do { _Pragma("unroll") for (int m = 0; m < 4; ++m) _Pragma("unroll") for (int k = 0; k < 2; ++k) dst[m][k] = *(const LAS bf16x8*)(lds + PG8_SA(b, h) + aoff + m * 2048 + k * 1024); } while (0)
#define PG8_LDB(dst, b, h) do { _Pragma("unroll") for (int n = 0; n < 2; ++n) _Pragma("unroll") for (int k = 0; k < 2; ++k) dst[n][k] = *(const LAS bf16x8*)(lds + PG8_SB(b, h) + boff + n * 2048 + k * 1024); } while (0)
#define PG8_MMA1(ai, bj, m, At, Bt, n, HALF_) do { f32x4 c_ = acc[ai][bj][m].HALF_; \
        if constexpr (FP8) c_ = __builtin_amdgcn_mfma_scale_f32_16x16x128_f8f6f4(cat8(Bt[n][0], Bt[n][1]), cat8(At[m][0], At[m][1]), c_, 0, 0, 0, 0, 0, 0); \
        else { _Pragma("unroll") for (int k = 0; k < 2; ++k) c_ = __builtin_amdgcn_mfma_f32_16x16x32_bf16(Bt[n][k], At[m][k], c_, 0, 0, 0); } \
        acc[ai][bj][m].HALF_ = c_; } while (0)
#define PG8_MMA(ai, bj, At, Bt) do { __builtin_amdgcn_s_setprio(1); _Pragma("unroll") for (int m = 0; m < 4; ++m) { PG8_MMA1(ai, bj, m, At, Bt, 0, lo); PG8_MMA1(ai, bj, m, At, Bt, 1, hi); } \
        __builtin_amdgcn_s_setprio(0); } while (0)
#define PG8_WAIT_V(n) asm volatile("s_waitcnt vmcnt(" #n ")" ::: "memory")
#define PG8_WAIT_L(n) asm volatile("s_waitcnt lgkmcnt(" #n ")" ::: "memory")
#define PG8_BAR __builtin_amdgcn_s_barrier()
#define PG8_SCHED __builtin_amdgcn_sched_barrier(0)
    Unit cur, nxt; int ui = 0;
    if (!S.next(0, cur)) return;
    const char* cA = cur.A; const char* cB = cur.B;
    int ntc = VARK ? cur.nt : g.nt; unsigned ldAc = VARK ? 128u * (unsigned)cur.nt : (unsigned)g.ldaB, ldBc = VARK ? 128u * (unsigned)cur.nt : (unsigned)g.ldbB;
    if constexpr (GATHER) {
#pragma unroll
        for (int h = 0; h < 2; ++h)
#pragma unroll
            for (int q = 0; q < 2; ++q) gof[h][q] = PG8_TOKOFF(0, h, q); }
    PG8_STAGE_B(PG8_SB(0, 0), cB, 0, ldBc); PG8_STAGE_B(PG8_SB(0, 1), cB, 1, ldBc); PG8_STAGE_A(PG8_SA(0, 0), cA, 0, ldAc); PG8_STAGE_A(PG8_SA(0, 1), cA, 1, ldAc);
    if (wr == 1) PG8_BAR;
    PG8_WAIT_V(2); PG8_BAR;
    PG8_STAGE_B(PG8_SB(1, 0), cB + kstep, 0, ldBc); PG8_STAGE_A(PG8_SA(1, 0), cA + kstep, 0, ldAc); PG8_STAGE_B(PG8_SB(1, 1), cB + kstep, 1, ldBc);
    PG8_WAIT_V(6); PG8_BAR;
    f32x8 acc[2][2][4];
#pragma unroll
    for (int a = 0; a < 2; ++a)
#pragma unroll
        for (int b = 0; b < 2; ++b)
#pragma unroll
            for (int m = 0; m < 4; ++m) acc[a][b][m] = (f32x8){0.f, 0.f, 0.f, 0.f, 0.f, 0.f, 0.f, 0.f};
    bf16x8 At[4][2], B0[2][2], B1[2][2];
    for (;;) {
        const bool has_next = S.next(ui + 1, nxt);
        const char* nA = has_next ? nxt.A : cA; const char* nB = has_next ? nxt.B : cB;
        const int ntn = (VARK && has_next) ? nxt.nt : ntc; const unsigned ldAn = (VARK && has_next) ? 128u * (unsigned)nxt.nt : ldAc, ldBn = (VARK && has_next) ? 128u * (unsigned)nxt.nt : ldBc;
#pragma nounroll
        for (int t = 0; t < ntc; t += 2) {
            const bool last = (t == ntc - 2);
            const char* a1 = cA + (size_t)(t + 1) * kstep;
            const char* a2 = last ? nA : cA + (size_t)(t + 2) * kstep; const char* b2 = last ? nB : cB + (size_t)(t + 2) * kstep;
            const char* a3 = a2 + kstep; const char* b3 = b2 + kstep;
            const unsigned ldAx = last ? ldAn : ldAc, ldBx = last ? ldBn : ldBc;
            if constexpr (GATHER) { if (last && has_next) { gof[0][0] = PG8_TOKOFF(ui + 1, 0, 0); gof[0][1] = PG8_TOKOFF(ui + 1, 0, 1); } }
            PG8_LDB(B0, 0, 0); PG8_LDB(B1, 0, 1); PG8_SCHED; PG8_LDA(At, 0, 0); PG8_STAGE_A(PG8_SA(1, 1), a1, 1, ldAc);
            if constexpr (GATHER) { if (last && has_next) { gof[1][0] = PG8_TOKOFF(ui + 1, 1, 0); gof[1][1] = PG8_TOKOFF(ui + 1, 1, 1); } }
            PG8_WAIT_V(8); PG8_WAIT_L(0); PG8_BAR; PG8_MMA(0, 0, At, B0); PG8_MMA(0, 1, At, B1); PG8_BAR; PG8_SCHED;
            PG8_LDA(At, 0, 1); PG8_STAGE_B(PG8_SB(0, 0), b2, 0, ldBx); PG8_STAGE_B(PG8_SB(0, 1), b2, 1, ldBx); PG8_STAGE_A(PG8_SA(0, 0), a2, 0, ldAx);
            PG8_WAIT_V(8); PG8_WAIT_L(0); PG8_BAR; PG8_MMA(1, 0, At, B0); PG8_MMA(1, 1, At, B1); PG8_BAR; PG8_SCHED;
            PG8_LDB(B0, 1, 0); PG8_LDB(B1, 1, 1); PG8_SCHED; PG8_LDA(At, 1, 0); PG8_STAGE_A(PG8_SA(0, 1), a2, 1, ldAx);
            PG8_WAIT_V(8); PG8_WAIT_L(0); PG8_BAR; PG8_MMA(0, 0, At, B0); PG8_MMA(0, 1, At, B1); PG8_BAR; PG8_SCHED;
            PG8_LDA(At, 1, 1); PG8_STAGE_B(PG8_SB(1, 0), b3, 0, ldBx); PG8_STAGE_B(PG8_SB(1, 1), b3, 1, ldBx); PG8_STAGE_A(PG8_SA(1, 0), a3, 0, ldAx);
            PG8_WAIT_V(8); PG8_WAIT_L(0); PG8_BAR; PG8_MMA(1, 0, At, B0); PG8_MMA(1, 1, At, B1); PG8_BAR; PG8_SCHED;
        }
        if (wr == 0) PG8_BAR;
        { const int lane2 = opq(lane_id()); f32x4 accv[2][2][4][2];
#pragma unroll
          for (int a = 0; a < 2; ++a)
#pragma unroll
              for (int b = 0; b < 2; ++b)
#pragma unroll
                  for (int m = 0; m < 4; ++m) { accv[a][b][m][0] = acc[a][b][m].lo; accv[a][b][m][1] = acc[a][b][m].hi; }
          if (!skip_epi) E(accv, cur, wr, wc, lane2 & 15, lane2 >> 4); }
        if (!has_next) break;
#pragma unroll
        for (int a = 0; a < 2; ++a)
#pragma unroll
            for (int b = 0; b < 2; ++b)
#pragma unroll
                for (int m = 0; m < 4; ++m) acc[a][b][m] = (f32x8){0.f, 0.f, 0.f, 0.f, 0.f, 0.f, 0.f, 0.f};
        cur = nxt; cA = nA; cB = nB; ntc = ntn; ldAc = ldAn; ldBc = ldBn; ++ui;
        if (wr == 1) PG8_BAR;
    }
    PG8_WAIT_V(0);
    PG8_BAR;
#undef PG8_SA
#undef PG8_SB
#undef PG8_STAGE_X
#undef PG8_STAGE_B
#undef PG8_STAGE_A
#undef PG8_TOKOFF
#undef PG8_LDA
#undef PG8_LDB
#undef PG8_MMA
#undef PG8_MMA1
#undef PG8_WAIT_V
#undef PG8_WAIT_L
#undef PG8_BAR
#undef PG8_SCHED
}
}
using pg8::Unit;

typedef f32x4 AccT[2][2][4][2];

struct EpiPool {
    static constexpr bool PERM = true;
    const float* x; const float* ctx; bf16_t* x1; const float* pb; const float* ps; const float* modv0;
    __device__ __forceinline__ void operator()(const AccT& acc, const Unit& u, int wr, int wc, int fr, int fq) const {
        const int bidx = u.pm < 64 ? (u.pm >> 3) : 8;
        const float* g1 = modv0 + (bidx * 6 + 2) * 1024;
        const float* src = u.pm < 64 ? x + (size_t)u.pm * 256 * 1024 : ctx + (size_t)(u.pm - 64) * 256 * 1024;
        bf16_t* dst = x1 + (size_t)u.pm * 256 * 1024;
        const int col0 = u.pn * 256 + wc * 32 + 8 * fq;
        f32x4 mul[2][2], add[2][2];
#pragma unroll
        for (int bj = 0; bj < 2; ++bj)
#pragma unroll
            for (int n = 0; n < 2; ++n) { const int c = col0 + bj * 128 + n * 4; const f32x4 bv = *(const f32x4*)(pb + c), sv = *(const f32x4*)(ps + c), gv = *(const f32x4*)(g1 + c);
                mul[bj][n] = sv * gv; add[bj][n] = bv * mul[bj][n]; }
#pragma unroll
        for (int ai = 0; ai < 2; ++ai)
#pragma unroll
            for (int m = 0; m < 4; ++m) { const size_t ro = (size_t)(ai * 128 + wr * 64 + m * 16 + fr) * 1024 + col0;
#pragma unroll
                for (int bj = 0; bj < 2; ++bj) { const f32x4 x0 = *(const f32x4*)(src + ro + bj * 128), x1v = *(const f32x4*)(src + ro + bj * 128 + 4);
                    *(u32x4*)(dst + ro + bj * 128) = pk8(x0 + acc[ai][bj][m][0] * mul[bj][0] + add[bj][0], x1v + acc[ai][bj][m][1] * mul[bj][1] + add[bj][1]); } }
    }
};

__device__ __forceinline__ f32x2 swiglu4_pk(f32x2 g, f32x2 u) {
    g.x = fminf(g.x, 7.0f); g.y = fminf(g.y, 7.0f);
    u.x = __builtin_amdgcn_fmed3f(u.x, -7.0f, 7.0f); u.y = __builtin_amdgcn_fmed3f(u.y, -7.0f, 7.0f);
    f32x2 t = g * (-1.702f * 1.4426950408889634f);
    t.x = __builtin_amdgcn_exp2f(t.x); t.y = __builtin_amdgcn_exp2f(t.y);
    t = t + 1.0f;
    t.x = __builtin_amdgcn_rcpf(t.x); t.y = __builtin_amdgcn_rcpf(t.y);
    return (u * 4.0f + 4.0f) * (g * t);
}
struct EpiGu {
    static constexpr bool PERM = true;
    unsigned char* act; const LAS float* biasl;
    __device__ __forceinline__ void operator()(const AccT& acc, const Unit& u, int wr, int wc, int fr, int fq) const {
        const LAS float* bias = biasl + u.nt * 256 + wc * 32 + 8 * fq; const int gcol0 = u.pn * 128 + wc * 32 + 8 * fq;
        f32x4 bg[2], bu[2];
#pragma unroll
        for (int n = 0; n < 2; ++n) { bg[n] = *(const LAS f32x4*)(bias + 4 * n); bu[n] = *(const LAS f32x4*)(bias + 128 + 4 * n); }
        unsigned char* ap = act + (size_t)u.pm * 256 * 1024 + (size_t)(wr * 64 + (fq & 1) * 16 + fr) * 1024 + u.pn * 128 + wc * 32 + 16 * (fq >> 1);
#pragma unroll
        for (int ai = 0; ai < 2; ++ai)
#pragma unroll
            for (int mp = 0; mp < 2; ++mp) {
                u32x2 w[2];
#pragma unroll
                for (int mo = 0; mo < 2; ++mo) { const int m = 2 * mp + mo;
#pragma unroll
                    for (int n = 0; n < 2; ++n) { const f32x4 gv = acc[ai][0][m][n] * (1.0f / 512.0f) + bg[n], uv = acc[ai][1][m][n] * (1.0f / 512.0f) + bu[n];
                        const f32x2 a0 = swiglu4_pk((f32x2){gv.x, gv.y}, (f32x2){uv.x, uv.y}), a1 = swiglu4_pk((f32x2){gv.z, gv.w}, (f32x2){uv.z, uv.w});
                        int p = __builtin_amdgcn_cvt_pk_fp8_f32(a0.x, a0.y, 0, false); p = __builtin_amdgcn_cvt_pk_fp8_f32(a1.x, a1.y, p, true); w[mo][n] = (unsigned)p; } }
                const auto r0 = __builtin_amdgcn_permlane16_swap(w[0].x, w[1].x, false, false), r1 = __builtin_amdgcn_permlane16_swap(w[0].y, w[1].y, false, false);
                const u32x4 o = {r0[0], r1[0], r0[1], r1[1]};
                *(u32x4*)(ap + (size_t)(ai * 128 + mp * 32) * 1024) = o; __builtin_amdgcn_sched_barrier(0); }
    }
};
struct EpiDown {
    static constexpr bool PERM = true;
    unsigned char* ys; const LAS float* biasl; const LAS int* aidl;
    __device__ __forceinline__ void operator()(const AccT& acc, const Unit& u, int wr, int wc, int fr, int fq) const {
        const LAS float* bias = biasl + u.nt * 256 + wc * 64 + 16 * fq; const int col0 = u.pn * 256 + wc * 64 + 16 * fq;
        f32x4 bv[4];
#pragma unroll
        for (int q = 0; q < 4; ++q) bv[q] = *(const LAS f32x4*)(bias + 4 * q) * 16.0f;
#pragma unroll
        for (int ai = 0; ai < 2; ++ai)
#pragma unroll
            for (int m = 0; m < 4; ++m) { const int r = ai * 128 + wr * 64 + m * 16 + fr; const int aid = aidl[u.nt * 256 + r]; const bool valid = aid >= 0;
                if (valid) { u32x4 w;
#pragma unroll
                    for (int bj = 0; bj < 2; ++bj)
#pragma unroll
                        for (int n = 0; n < 2; ++n) w[2 * bj + n] = pk_fp8x4(acc[ai][bj][m][n] * (1.0f / 16.0f) + bv[2 * bj + n]);
                    *(u32x4*)(ys + (size_t)aid * 1024 + col0) = w; } __builtin_amdgcn_sched_barrier(0); }
    }
};
__device__ __forceinline__ void row_bk(int row, int& b, int& key) { if (row < NL) { b = row >> 11; key = CTXL + (row & 2047); } else { const int r = row - NL; b = r >> 8; key = r & 255; } }
__device__ __forceinline__ void rope_rot(f32x4 x1, f32x4 x2, const f32x2* rope, int pos, int fq, bool rot, f32x4& o1, f32x4& o2) {
    o1 = x1; o2 = x2;
    if (rot) {
#pragma unroll
        for (int j = 0; j < 4; ++j) { const f32x2 cs = rope[pos * 16 + 4 * fq + j]; o1[j] = x1[j] * cs.x - x2[j] * cs.y; o2[j] = x2[j] * cs.x + x1[j] * cs.y; } }
}
struct EpiP1 {
    static constexpr bool PERM = true;
    unsigned char* qa; unsigned char* ckv; float* ssq;
    __device__ __forceinline__ void operator()(const AccT& acc, const Unit& u, int wr, int wc, int fr, int fq) const {
        const int row0 = u.pm * 256 + wr * 64 + fr;
        unsigned char* dst = u.pn < 2 ? qa : ckv; const int ld = u.pn < 2 ? 512 : 256, colt = (u.pn < 2 ? u.pn * 256 : 0) + wc * 32 + 8 * fq;
#pragma unroll
        for (int ai = 0; ai < 2; ++ai)
#pragma unroll
            for (int m = 0; m < 4; ++m) { const int row = row0 + ai * 128 + m * 16; float ss = 0.f;
#pragma unroll
                for (int bj = 0; bj < 2; ++bj) { const f32x4 v0 = acc[ai][bj][m][0] * (1.0f / 512.0f), v1 = acc[ai][bj][m][1] * (1.0f / 512.0f);
                    ss += (v0[0] * v0[0] + v0[1] * v0[1]) + (v0[2] * v0[2] + v0[3] * v0[3]) + (v1[0] * v1[0] + v1[1] * v1[1]) + (v1[2] * v1[2] + v1[3] * v1[3]);
                    *(u32x2*)(dst + (size_t)row * ld + colt + bj * 128) = pk_fp8x8(v0, v1, 8.0f); }
                ss += __shfl_xor(ss, 16); ss += __shfl_xor(ss, 32);
                if (fq == 0) ssq[(size_t)(u.pn * 4 + wc) * NT + row] = ss; }
    }
};
struct EpiKpe {
    static constexpr bool PERM = true;
    unsigned char* Kb; const f32x2* rope;
    __device__ __forceinline__ void operator()(const AccT& acc, const Unit& u, int wr, int wc, int fr, int fq) const {
        if (wc >= 2) return;
        const int row0 = u.pm * 256 + wr * 64 + fr;
#pragma unroll
        for (int ai = 0; ai < 2; ++ai)
#pragma unroll
            for (int m = 0; m < 4; ++m) { const int row = row0 + ai * 128 + m * 16; int b, key; row_bk(row, b, key);
                const int l = row & 2047, pos = wc == 0 ? (l >> 6) : (l & 63);
                f32x4 o1, o2; rope_rot(acc[ai][0][m][0] * (1.0f / 512.0f), acc[ai][0][m][1] * (1.0f / 512.0f), rope, pos, fq, row < NL, o1, o2);
                const u32x2 w = pk_fp8x8(o1, o2, 4.0f);
                unsigned char* kd = Kb + ((size_t)(b * NH) * SKV + key) * DQK + DNOPE + wc * 32 + 8 * fq;
#pragma unroll
                for (int h = 0; h < NH; ++h) *(u32x2*)(kd + (size_t)h * SKV * DQK) = w; }
    }
};
struct EpiUq {
    static constexpr bool PERM = true;
    unsigned char* Q; const LAS float* rinvl; const f32x2* rope;
    __device__ __forceinline__ void operator()(const AccT& acc, const Unit& u, int wr, int wc, int fr, int fq) const {
#pragma unroll
        for (int ai = 0; ai < 2; ++ai)
#pragma unroll
            for (int m = 0; m < 4; ++m) { const int rl = ai * 128 + wr * 64 + m * 16 + fr, row = u.pm * 256 + rl;
                const float rinv = rinvl[u.mt * 256 + rl];
                const int b = row >> 11, l = row & 2047;
#pragma unroll
                for (int bj = 0; bj < 2; ++bj) { const int cb = 8 * u.pn + 4 * bj + wc, head = cb / 6, wb = cb % 6;
                    unsigned char* dr = Q + ((size_t)(b * NH + head) * SEQ + l) * DQK;
                    const f32x4 v0 = acc[ai][bj][m][0] * rinv, v1 = acc[ai][bj][m][1] * rinv;
                    if (wb < 4) *(u32x2*)(dr + wb * 32 + 8 * fq) = pk_fp8x8(v0, v1, 4.0f);
                    else { const int axis = wb - 4, pos = axis == 0 ? (l >> 6) : (l & 63); f32x4 o1, o2; rope_rot(v0, v1, rope, pos, fq, true, o1, o2);
                        *(u32x2*)(dr + DNOPE + axis * 32 + 8 * fq) = pk_fp8x8(o1, o2, 4.0f); } } }
    }
};
struct EpiUkv {
    static constexpr bool PERM = true;
    unsigned char* Kb; bf16_t* Vb; const LAS float* rinvl;
    __device__ __forceinline__ void operator()(const AccT& acc, const Unit& u, int wr, int wc, int fr, int fq) const {
#pragma unroll
        for (int ai = 0; ai < 2; ++ai)
#pragma unroll
            for (int m = 0; m < 4; ++m) { const int rl = ai * 128 + wr * 64 + m * 16 + fr, row = u.pm * 256 + rl;
                const float rinv = rinvl[u.mt * 256 + rl];
                int b, key; row_bk(row, b, key);
                const size_t kr = (size_t)(b * NH + u.pn) * SKV + key;
                { const f32x4 v0 = acc[ai][0][m][0] * rinv, v1 = acc[ai][0][m][1] * rinv; *(u32x2*)(Kb + kr * DQK + wc * 32 + 8 * fq) = pk_fp8x8(v0, v1, 4.0f); }
                { const f32x4 v0 = acc[ai][1][m][0] * rinv, v1 = acc[ai][1][m][1] * rinv;
                  u32x4 w; w.x = cvt_pk_bf16(v0[0], v0[1]); w.y = cvt_pk_bf16(v0[2], v0[3]); w.z = cvt_pk_bf16(v1[0], v1[1]); w.w = cvt_pk_bf16(v1[2], v1[3]);
                  gst16(Vb + kr * DV + wc * 32 + 8 * fq, w); } }
    }
};
struct EpiWo {
    static constexpr bool PERM = true;
    const bf16_t* x2; bf16_t* x3; const float* modv1;
    __device__ __forceinline__ void operator()(const AccT& acc, const Unit& u, int wr, int wc, int fr, int fq) const {
        const float* g1 = modv1 + ((u.pm >> 3) * 6 + 2) * 1024; const int col0 = u.pn * 256 + wc * 32 + 8 * fq;
        f32x4 gv[2][2];
#pragma unroll
        for (int bj = 0; bj < 2; ++bj)
#pragma unroll
            for (int n = 0; n < 2; ++n) gv[bj][n] = *(const f32x4*)(g1 + col0 + bj * 128 + n * 4) * (1.0f / 4096.0f);
#pragma unroll
        for (int ai = 0; ai < 2; ++ai)
#pragma unroll
            for (int m = 0; m < 4; ++m) { const size_t ro = (size_t)(u.pm * 256 + ai * 128 + wr * 64 + m * 16 + fr) * 1024 + col0;
#pragma unroll
                for (int bj = 0; bj < 2; ++bj) { f32x4 xa, xb; unpk8(*(const u32x4*)(x2 + ro + bj * 128), xa, xb);
                    *(u32x4*)(x3 + ro + bj * 128) = pk8(xa + acc[ai][bj][m][0] * gv[bj][0], xb + acc[ai][bj][m][1] * gv[bj][1]); } }
    }
};
struct EpiProj2 {
    static constexpr bool PERM = true;
    EpiKpe k; EpiUq q; EpiUkv v;
    __device__ __forceinline__ void operator()(const AccT& acc, const Unit& u, int wr, int wc, int fr, int fq) const {
        if (u.e == 0) k(acc, u, wr, wc, fr, fq); else if (u.e == 1) q(acc, u, wr, wc, fr, fq); else v(acc, u, wr, wc, fr, fq);
    }
};
struct KpeSched {
    int c; const char* A; const char* B;
    __device__ __forceinline__ bool next(int i, Unit& u) const {
        if (i > 0 || c >= NT / 256) return false;
        u.pm = c; u.pn = 3; u.e = 0; u.mt = 0; u.nv = 256; u.nt = 0; u.A = A + (size_t)c * 256 * 1024; u.B = B; return true;
    }
};
struct Proj2Sched {
    const LAS int* tab; int n;
    __device__ __forceinline__ bool next(int i, Unit& u) const {
        if (i >= n) return false;
        u.pm = __builtin_amdgcn_readfirstlane(tab[8 * i]); u.pn = __builtin_amdgcn_readfirstlane(tab[8 * i + 1]); u.e = __builtin_amdgcn_readfirstlane(tab[8 * i + 2]); u.nt = __builtin_amdgcn_readfirstlane(tab[8 * i + 3]);
        u.mt = i; u.nv = 256;
        const unsigned alo = __builtin_amdgcn_readfirstlane(tab[8 * i + 4]), ahi = __builtin_amdgcn_readfirstlane(tab[8 * i + 5]), blo = __builtin_amdgcn_readfirstlane(tab[8 * i + 6]), bhi = __builtin_amdgcn_readfirstlane(tab[8 * i + 7]);
        u.A = (const char*)(((unsigned long long)ahi << 32) | alo); u.B = (const char*)(((unsigned long long)bhi << 32) | blo); return true;
    }
};

namespace att {
constexpr int QBLK = 32, KVBLK = 64, KROW = 208;
constexpr float SCALE = 0.07216878364870322f / 16.0f;
constexpr float THR = 8.f;
constexpr int NST = 3, SHM_V = KVBLK * DV * 2, SHM_K = KVBLK * KROW, LDS_NEED = NST * SHM_V + NST * SHM_K + NWAVES * 64 * 4;
#define SBAR() __builtin_amdgcn_sched_barrier(0)
__device__ __forceinline__ int crow(int r, int hi) { return (r & 3) + 8 * (r >> 2) + 4 * hi; }
__device__ __forceinline__ void partialSM(f32x16& p0, f32x16& p1, float& m_reg, float& mn, float& alpha) {
    constexpr float C = SCALE * 1.4426950408889634f;
    float pmax = p0[0];
#pragma unroll
    for (int r = 1; r < 16; ++r) pmax = fmaxf(pmax, p0[r]);
#pragma unroll
    for (int r = 0; r < 16; ++r) pmax = fmaxf(pmax, p1[r]);
    { auto rr = __builtin_amdgcn_permlane32_swap(__float_as_uint(pmax), __float_as_uint(pmax), false, false);
      pmax = fmaxf(__uint_as_float(rr[0]), __uint_as_float(rr[1])); }
    if (__builtin_expect(__all(pmax - m_reg <= THR / SCALE), 1)) { mn = m_reg; alpha = 1.f; }
    else { mn = fmaxf(m_reg, pmax); alpha = __builtin_amdgcn_exp2f((m_reg - mn) * C); m_reg = mn; }
    const float mnC = -mn * C;
#pragma unroll
    for (int r = 0; r < 16; ++r) p0[r] = fmaf(p0[r], C, mnC);
#pragma unroll
    for (int r = 0; r < 16; ++r) p1[r] = fmaf(p1[r], C, mnC);
#pragma unroll
    for (int r = 0; r < 16; ++r) p0[r] = __builtin_amdgcn_exp2f(p0[r]);
}
template <int VAR = 0> __device__ __forceinline__ void finishSM(f32x16& p0, f32x16& p1, float alpha, float& l_reg, bf16x8& pa0, bf16x8& pa1, bf16x8& pa2, bf16x8& pa3) {
    if constexpr (!(VAR & 1)) {
#pragma unroll
    for (int r = 0; r < 16; ++r) p1[r] = __builtin_amdgcn_exp2f(p1[r]); }
    float ps = 0;
#pragma unroll
    for (int r = 0; r < 16; ++r) ps += p0[r];
#pragma unroll
    for (int r = 0; r < 16; ++r) ps += p1[r];
    { auto rr = __builtin_amdgcn_permlane32_swap(__float_as_uint(ps), __float_as_uint(ps), false, false);
      ps = __uint_as_float(rr[0]) + __uint_as_float(rr[1]); }
    l_reg = l_reg * alpha + ps;
#define PK4(P, BASE, OUT) do { unsigned a0 = cvt_pk_bf16(P[BASE + 0], P[BASE + 1]), a1 = cvt_pk_bf16(P[BASE + 2], P[BASE + 3]);   \
    unsigned b0 = cvt_pk_bf16(P[BASE + 4], P[BASE + 5]), b1 = cvt_pk_bf16(P[BASE + 6], P[BASE + 7]);                              \
    auto r0 = __builtin_amdgcn_permlane32_swap(a0, b0, false, false); auto r1 = __builtin_amdgcn_permlane32_swap(a1, b1, false, false); \
    u32x4 w = {r0[0], r1[0], r0[1], r1[1]}; OUT = *reinterpret_cast<bf16x8*>(&w); } while (0)
    PK4(p0, 0, pa0); PK4(p0, 8, pa1); PK4(p1, 0, pa2); PK4(p1, 8, pa3);
#undef PK4
}
typedef int i32x8a __attribute__((ext_vector_type(8)));
typedef int i32x4a __attribute__((ext_vector_type(4)));
__device__ __forceinline__ void qkt(f32x16& p0, f32x16& p1, const LAS unsigned char* Ks, const i32x8a* qr, int r32, int hi) {
    p0 = f32x16{}; p1 = f32x16{};
#pragma unroll
    for (int c = 0; c < 3; ++c) { const int cb = c * 64 + hi * 32;
        const i32x4a a0 = *(const LAS i32x4a*)(Ks + r32 * KROW + cb), a1 = *(const LAS i32x4a*)(Ks + r32 * KROW + cb + 16);
        const i32x4a b0 = *(const LAS i32x4a*)(Ks + (32 + r32) * KROW + cb), b1 = *(const LAS i32x4a*)(Ks + (32 + r32) * KROW + cb + 16);
        p0 = __builtin_amdgcn_mfma_scale_f32_32x32x64_f8f6f4(__builtin_shufflevector(a0, a1, 0, 1, 2, 3, 4, 5, 6, 7), qr[c], p0, 0, 0, 0, 0, 0, 0);
        p1 = __builtin_amdgcn_mfma_scale_f32_32x32x64_f8f6f4(__builtin_shufflevector(b0, b1, 0, 1, 2, 3, 4, 5, 6, 7), qr[c], p1, 0, 0, 0, 0, 0, 0); }
}
__device__ __forceinline__ int v_st(int k, int c) { const int kk = (k & ~0xC) | ((k & 4) << 1) | ((k & 8) >> 1); return ((kk >> 3) * 4 + (c >> 5)) * 512 + ((kk & 7) * 32 + (c & 31)) * 2; }
__device__ __forceinline__ int v_rd_base(int lane) { return ((lane & 3) << 3) | (((lane >> 2) & 3) << 6) | (((lane >> 4) & 1) << 5) | (((lane >> 5) & 1) << 8); }
constexpr int v_rd_off(int d0, int ks, int half) { return d0 * 512 + ks * 4096 + half * 2048; }
template <int OFF> __device__ __forceinline__ s16x4 tr_read(int vb) {
    s16x4 r; asm volatile("ds_read_b64_tr_b16 %0, %1 offset:%2" : "=&v"(r) : "v"(vb), "i"(OFF) : "memory"); return r;
}
template <int D0> __device__ __forceinline__ void pv_one(f32x16& od, int vb, bf16x8 pa0, bf16x8 pa1, bf16x8 pa2, bf16x8 pa3) {
    const s16x4 l0 = tr_read<v_rd_off(D0, 0, 0)>(vb), h0 = tr_read<v_rd_off(D0, 0, 1)>(vb), l1 = tr_read<v_rd_off(D0, 1, 0)>(vb), h1 = tr_read<v_rd_off(D0, 1, 1)>(vb);
    const s16x4 l2 = tr_read<v_rd_off(D0, 2, 0)>(vb), h2 = tr_read<v_rd_off(D0, 2, 1)>(vb), l3 = tr_read<v_rd_off(D0, 3, 0)>(vb), h3 = tr_read<v_rd_off(D0, 3, 1)>(vb);
    asm volatile("s_waitcnt lgkmcnt(0)" ::: "memory"); SBAR();
#define PK(L, H) (bf16x8){L[0], L[1], L[2], L[3], H[0], H[1], H[2], H[3]}
    od = __builtin_amdgcn_mfma_f32_32x32x16_bf16(pa0, PK(l0, h0), od, 0, 0, 0);
    od = __builtin_amdgcn_mfma_f32_32x32x16_bf16(pa1, PK(l1, h1), od, 0, 0, 0);
    od = __builtin_amdgcn_mfma_f32_32x32x16_bf16(pa2, PK(l2, h2), od, 0, 0, 0);
    od = __builtin_amdgcn_mfma_f32_32x32x16_bf16(pa3, PK(l3, h3), od, 0, 0, 0);
#undef PK
}
__device__ __forceinline__ void pv_d0(f32x16* o, int vb, bf16x8 pa0, bf16x8 pa1, bf16x8 pa2, bf16x8 pa3) {
    pv_one<0>(o[0], vb, pa0, pa1, pa2, pa3); pv_one<1>(o[1], vb, pa0, pa1, pa2, pa3); pv_one<2>(o[2], vb, pa0, pa1, pa2, pa3); pv_one<3>(o[3], vb, pa0, pa1, pa2, pa3);
}
struct VFrag { s16x4 l0, h0, l1, h1, l2, h2, l3, h3; };
template <int D0> __device__ __forceinline__ void pv_reads(VFrag& f, int vb) {
    f.l0 = tr_read<v_rd_off(D0, 0, 0)>(vb); f.h0 = tr_read<v_rd_off(D0, 0, 1)>(vb); f.l1 = tr_read<v_rd_off(D0, 1, 0)>(vb); f.h1 = tr_read<v_rd_off(D0, 1, 1)>(vb);
    f.l2 = tr_read<v_rd_off(D0, 2, 0)>(vb); f.h2 = tr_read<v_rd_off(D0, 2, 1)>(vb); f.l3 = tr_read<v_rd_off(D0, 3, 0)>(vb); f.h3 = tr_read<v_rd_off(D0, 3, 1)>(vb);
}
__device__ __forceinline__ void pv_mma(f32x16& od, const VFrag& f, bf16x8 pa0, bf16x8 pa1, bf16x8 pa2, bf16x8 pa3) {
#define PK(L, H) (bf16x8){L[0], L[1], L[2], L[3], H[0], H[1], H[2], H[3]}
    od = __builtin_amdgcn_mfma_f32_32x32x16_bf16(pa0, PK(f.l0, f.h0), od, 0, 0, 0);
    od = __builtin_amdgcn_mfma_f32_32x32x16_bf16(pa1, PK(f.l1, f.h1), od, 0, 0, 0);
    od = __builtin_amdgcn_mfma_f32_32x32x16_bf16(pa2, PK(f.l2, f.h2), od, 0, 0, 0);
    od = __builtin_amdgcn_mfma_f32_32x32x16_bf16(pa3, PK(f.l3, f.h3), od, 0, 0, 0);
#undef PK
}
__device__ __forceinline__ float sm_max(const f32x16& p0, const f32x16& p1) {
    float a = fmaxf(fmaxf(p0[0], p0[1]), p0[2]), b = fmaxf(fmaxf(p1[0], p1[1]), p1[2]);
#pragma unroll
    for (int r = 3; r < 15; r += 2) { a = fmaxf(fmaxf(a, p0[r]), p0[r + 1]); b = fmaxf(fmaxf(b, p1[r]), p1[r + 1]); }
    float pmax = fmaxf(fmaxf(a, b), fmaxf(p0[15], p1[15]));
    auto rr = __builtin_amdgcn_permlane32_swap(__float_as_uint(pmax), __float_as_uint(pmax), false, false);
    return fmaxf(__uint_as_float(rr[0]), __uint_as_float(rr[1]));
}
__device__ __forceinline__ void sm_scale(f32x16& p0, f32x16& p1, float pmax, float& m_reg, float& alpha) {
    constexpr float C = SCALE * 1.4426950408889634f; float mn;
    const bool keep = __all(pmax - m_reg <= THR / SCALE);
    mn = keep ? m_reg : fmaxf(m_reg, pmax); alpha = keep ? 1.f : __builtin_amdgcn_exp2f((m_reg - mn) * C); m_reg = mn;
    const float mnC = -mn * C; float cv = C; asm volatile("" : "+v"(cv));
#pragma unroll
    for (int r = 0; r < 16; ++r) { float a = p0[r], b = p1[r]; asm("v_fma_f32 %0, %0, %1, %2" : "+v"(a) : "v"(cv), "v"(mnC)); asm("v_fma_f32 %0, %0, %1, %2" : "+v"(b) : "v"(cv), "v"(mnC)); p0[r] = a; p1[r] = b; }
}
__device__ __forceinline__ void sm_exp(f32x16& p) {
#pragma unroll
    for (int r = 0; r < 16; ++r) p[r] = __builtin_amdgcn_exp2f(p[r]);
}
template <int VAR = 0>
__device__ __forceinline__ void attn_unit(const unsigned char* __restrict__ Qb, const unsigned char* __restrict__ Kh, const bf16_t* __restrict__ Vh, unsigned char* __restrict__ Ob, LAS unsigned char* lds, int wave_s) {
    const int lane = opq(lane_id()), wid = wave_s, tid = wid * 64 + lane, r32 = lane & 31, hi = lane >> 5;
    LAS unsigned char* V_lds = lds; LAS unsigned char* K_lds = lds + NST * SHM_V;
    LAS float* ws = (LAS float*)(lds + NST * SHM_V + NST * SHM_K) + wid * 64; LAS float* li_l = ws; LAS float* al_l = ws + 32;
    float m_reg = -1e30f, l_reg = 0; f32x16 o[4] = {}; i32x8a qr[3];
    const unsigned char* Qw = Qb + (size_t)(wid * QBLK + r32) * DQK + hi * 32;
#pragma unroll
    for (int c = 0; c < 3; ++c) { const i32x4a q0 = *(const i32x4a*)(Qw + c * 64), q1 = *(const i32x4a*)(Qw + c * 64 + 16); qr[c] = __builtin_shufflevector(q0, q1, 0, 1, 2, 3, 4, 5, 6, 7); }
    unsigned kofs[2], vofs[2];
#pragma unroll
    for (int sl = 0; sl < 2; ++sl) { const int p = 64 * (wid + 8 * sl) + lane, row = (p * 5042) >> 16, c = p - 13 * row;
        kofs[sl] = (unsigned)(row * DQK + (c < 12 ? c : 11) * 16);
        const int sub = p >> 5, within = p & 31, kk = (sub >> 2) * 8 + (within >> 2), cc = (sub & 3) * 32 + (within & 3) * 8, k = (kk & ~0xC) | ((kk & 4) << 1) | ((kk & 8) >> 1);
        vofs[sl] = (unsigned)(k * DV * 2 + cc * 2); }
    const int vb0 = (int)(uintptr_t)V_lds + v_rd_base(lane);
#define SDMA(k0, st) do { if constexpr (!(VAR & 16)) { \
    const char* kb_ = uni_ptr((const char*)Kh + (size_t)(k0) * DQK); asm volatile("" : "+s"(kb_)); const char* vg_ = uni_ptr((const char*)Vh + (size_t)(k0) * DV * 2); asm volatile("" : "+s"(vg_)); \
    LAS unsigned char* kd_ = K_lds + (st) * SHM_K + wid * 1024; LAS unsigned char* vd_ = V_lds + (st) * SHM_V + wid * 1024; \
    __builtin_amdgcn_global_load_lds((const unsigned*)(kb_ + kofs[0]), (LAS unsigned*)kd_, 16, 0, 0); \
    if (wid < 5) __builtin_amdgcn_global_load_lds((const unsigned*)(kb_ + kofs[1]), (LAS unsigned*)(kd_ + 8192), 16, 0, 0); \
    __builtin_amdgcn_global_load_lds((const unsigned*)(vg_ + vofs[0]), (LAS unsigned*)vd_, 16, 0, 0); \
    __builtin_amdgcn_global_load_lds((const unsigned*)(vg_ + vofs[1]), (LAS unsigned*)(vd_ + 8192), 16, 0, 0); } } while (0)
#define SWAIT() asm volatile("s_waitcnt vmcnt(0)" ::: "memory")
#define RESC(a) do { if (__any((a) < 1.f)) { if (hi == 0) al_l[r32] = (a); asm volatile("s_waitcnt lgkmcnt(0)" ::: "memory"); \
    _Pragma("unroll") for (int d = 0; d < 4; ++d) _Pragma("unroll") for (int r = 0; r < 16; ++r) o[d][r] *= al_l[crow(r, hi)]; } } while (0)
    f32x16 pA0, pA1, pB0, pB1; float mnA, alA, alB; bf16x8 pa0, pa1, pa2, pa3; constexpr int NTL = SKV / KVBLK;
    SDMA(0, 0); SDMA(KVBLK, 1); SWAIT(); __syncthreads();
    qkt(pA0, pA1, K_lds, qr, r32, hi); partialSM(pA0, pA1, m_reg, mnA, alA);
    VFrag fa, fb; float pmx;
    int sV = 0, sK = 1, sW = 2;
#define WAITF(n, f) asm volatile("s_waitcnt lgkmcnt(" #n ")" : "+v"(f.l0), "+v"(f.h0), "+v"(f.l1), "+v"(f.h1), "+v"(f.l2), "+v"(f.h2), "+v"(f.l3), "+v"(f.h3) :: "memory")
#define PKB(L, H) (bf16x8){L[0], L[1], L[2], L[3], H[0], H[1], H[2], H[3]}
#define MM(OD, PA, L, H) do { if constexpr (!(VAR & 2)) OD = __builtin_amdgcn_mfma_f32_32x32x16_bf16(PA, PKB(L, H), OD, 0, 0, 0); SBAR(); } while (0)
#define SL(...) do { __VA_ARGS__; SBAR(); } while (0)
#define MAX3(a, x, y) a = fmaxf(fmaxf(a, x), y)
#define PIN1(x) asm volatile("" : "+v"(x))
#define PINV(P) asm volatile("" : "+v"(P))
#define FM(P, r) do { float t_ = P[r]; asm volatile("v_fma_f32 %0, %0, %1, %2" : "+v"(t_) : "v"(cvm_), "v"(mnc_)); P[r] = t_; } while (0)
#define EX(P, r) do { if constexpr (!(VAR & 1)) P[r] = __builtin_amdgcn_exp2f(P[r]); } while (0)
    constexpr float CSM = SCALE * 1.4426950408889634f; float cvm_ = CSM; asm volatile("" : "+v"(cvm_)); float ma_, mb_, mnc_;
#define TILE(PN0, PN1, PO0, PO1, ALO, ALN, NEXTK0) do { \
        SBAR(); SDMA(NEXTK0, sW); SBAR(); \
        const int vb_ = vb0 + sV * SHM_V; \
        if constexpr (!(VAR & 4)) qkt(PN0, PN1, K_lds + sK * SHM_K, qr, r32, hi); else { PN0 = f32x16{}; PN1 = f32x16{}; asm volatile("" : "+v"(PN0), "+v"(PN1)); } \
        pv_reads<0>(fa, vb_); \
        finishSM<VAR>(PO0, PO1, ALO, l_reg, pa0, pa1, pa2, pa3); SBAR(); \
          \
        pv_reads<1>(fb, vb_); WAITF(8, fa); \
        MM(o[0], pa0, fa.l0, fa.h0); SL(ma_ = fmaxf(fmaxf(PN0[0], PN0[1]), PN0[2]); MAX3(ma_, PN0[3], PN0[4]); MAX3(ma_, PN0[5], PN0[6]); MAX3(ma_, PN0[7], PN0[8]); MAX3(ma_, PN0[9], PN0[10]); MAX3(ma_, PN0[11], PN0[12]); PIN1(ma_)); \
        MM(o[0], pa1, fa.l1, fa.h1); SL(MAX3(ma_, PN0[13], PN0[14]); mb_ = fmaxf(fmaxf(PN0[15], PN1[0]), PN1[1]); MAX3(mb_, PN1[2], PN1[3]); MAX3(mb_, PN1[4], PN1[5]); MAX3(mb_, PN1[6], PN1[7]); MAX3(mb_, PN1[8], PN1[9]); PIN1(ma_); PIN1(mb_)); \
        MM(o[0], pa2, fa.l2, fa.h2); SL(MAX3(mb_, PN1[10], PN1[11]); MAX3(mb_, PN1[12], PN1[13]); MAX3(mb_, PN1[14], PN1[15]); pmx = fmaxf(ma_, mb_); \
            { auto rr_ = __builtin_amdgcn_permlane32_swap(__float_as_uint(pmx), __float_as_uint(pmx), false, false); pmx = fmaxf(__uint_as_float(rr_[0]), __uint_as_float(rr_[1])); } PIN1(pmx)); \
        MM(o[0], pa3, fa.l3, fa.h3); SL({ const bool keep_ = __all(pmx - m_reg <= THR / SCALE); const float mn_ = keep_ ? m_reg : fmaxf(m_reg, pmx); ALN = keep_ ? 1.f : __builtin_amdgcn_exp2f((m_reg - mn_) * CSM); m_reg = mn_; mnc_ = -mn_ * CSM; } PIN1(mnc_); PIN1(ALN)); \
        pv_reads<2>(fa, vb_); WAITF(8, fb); \
        MM(o[1], pa0, fb.l0, fb.h0); SL(FM(PN0, 0); FM(PN0, 1); FM(PN0, 2); FM(PN0, 3); FM(PN0, 4); FM(PN0, 5)); \
        MM(o[1], pa1, fb.l1, fb.h1); SL(FM(PN0, 6); FM(PN0, 7); FM(PN0, 8); FM(PN0, 9); FM(PN0, 10); FM(PN0, 11)); \
        MM(o[1], pa2, fb.l2, fb.h2); SL(FM(PN0, 12); FM(PN0, 13); FM(PN0, 14); FM(PN0, 15); FM(PN1, 0)); \
        MM(o[1], pa3, fb.l3, fb.h3); SL(FM(PN1, 1); FM(PN1, 2); FM(PN1, 3); FM(PN1, 4); FM(PN1, 5)); \
        pv_reads<3>(fb, vb_); WAITF(8, fa); \
        MM(o[2], pa0, fa.l0, fa.h0); SL(FM(PN1, 6); FM(PN1, 7); FM(PN1, 8); FM(PN1, 9); FM(PN1, 10)); \
        MM(o[2], pa1, fa.l1, fa.h1); SL(FM(PN1, 11); FM(PN1, 12); FM(PN1, 13); FM(PN1, 14); FM(PN1, 15)); \
        MM(o[2], pa2, fa.l2, fa.h2); SL(EX(PN0, 0); EX(PN0, 1); EX(PN0, 2); PINV(PN0)); \
        MM(o[2], pa3, fa.l3, fa.h3); SL(EX(PN0, 3); EX(PN0, 4); EX(PN0, 5); PINV(PN0)); \
        WAITF(0, fb); \
        MM(o[3], pa0, fb.l0, fb.h0); SL(EX(PN0, 6); EX(PN0, 7); EX(PN0, 8); PINV(PN0)); \
        MM(o[3], pa1, fb.l1, fb.h1); SL(EX(PN0, 9); EX(PN0, 10); EX(PN0, 11); PINV(PN0)); \
        MM(o[3], pa2, fb.l2, fb.h2); SL(EX(PN0, 12); EX(PN0, 13); PINV(PN0)); \
        MM(o[3], pa3, fb.l3, fb.h3); SL(EX(PN0, 14); EX(PN0, 15); PINV(PN0)); \
        asm volatile("" : "+v"(PN0), "+v"(PN1)); SBAR(); \
        RESC(ALN); SWAIT(); if constexpr (!(VAR & 8)) __syncthreads(); \
        sV = sK; sK = sW; sW = sW == NST - 1 ? 0 : sW + 1; } while (0)
    for (int j = 1; j + 1 < NTL; j += 2) {
        TILE(pB0, pB1, pA0, pA1, alA, alB, (j + 1) * KVBLK);
        TILE(pA0, pA1, pB0, pB1, alB, alA, (j + 2) * KVBLK);
    }
#undef TILE
#undef WAITF
#undef PKB
#undef MM
#undef SL
#undef MAX3
#undef PIN1
#undef PINV
#undef FM
#undef EX
    SBAR(); qkt(pB0, pB1, K_lds + sK * SHM_K, qr, r32, hi);
    finishSM(pA0, pA1, alA, l_reg, pa0, pa1, pa2, pa3); SBAR();
    pv_d0(o, vb0 + sV * SHM_V, pa0, pa1, pa2, pa3); partialSM(pB0, pB1, m_reg, mnA, alB);
    RESC(alB);
    finishSM(pB0, pB1, alB, l_reg, pa0, pa1, pa2, pa3); SBAR();
    pv_d0(o, vb0 + sK * SHM_V, pa0, pa1, pa2, pa3);
    if (hi == 0) li_l[r32] = l_reg; asm volatile("s_waitcnt lgkmcnt(0)" ::: "memory");
    float rli[16];
#pragma unroll
    for (int r = 0; r < 16; ++r) rli[r] = __builtin_amdgcn_rcpf(li_l[crow(r, hi)]);
    __syncthreads();
    const int tid2 = opq(tid), wid2 = tid2 >> 6, lane2 = tid2 & 63, r32b = lane2 & 31, hib = lane2 >> 5;
    LAS unsigned char* ost = lds + wid2 * 4096;
#pragma unroll
    for (int r = 0; r < 16; ++r) { const int orow = crow(r, hib);
#pragma unroll
        for (int d0 = 0; d0 < 4; ++d0) { const float v = clamp8(o[d0][r] * rli[r] * 64.0f); ost[orow * 128 + d0 * 32 + r32b] = (unsigned char)(__builtin_amdgcn_cvt_pk_fp8_f32(v, v, 0, false) & 0xff); } }
    asm volatile("s_waitcnt lgkmcnt(0)" ::: "memory");
    unsigned char* Ow = Ob + (size_t)(wid2 * QBLK) * 1024;
#pragma unroll
    for (int i = 0; i < 4; ++i) { const int id = lane2 + 64 * i, rr = id >> 3, ch = id & 7;
        const u32x4 w = *(const LAS u32x4*)(ost + rr * 128 + ch * 16);
        gst16(Ow + (size_t)rr * 1024 + ch * 16, (u32x4)(w)); }
#undef SDMA
#undef SWAIT
#undef RESC
}
}

struct Frame {
    LAS unsigned char* lds; LAS unsigned char* misc;
    unsigned* ctl; unsigned char* ws;
    int tid, lane, wave, vcu, G;
    const float* in[25];
    float* out;
};
struct Args { const float* in[25]; float* out; unsigned char* ws; int ph_lo, ph_hi; };

__device__ __forceinline__ void transpose_item(const float* W, int N, int K, bf16_t* WT, int k0, int n0, int rbase, bool perm, const float* kscale, LAS float* scr, int lane) {
#pragma unroll 8
    for (int i = 0; i < 32; ++i) { const int kk = 2 * i + (lane >> 5); float v = W[(size_t)(k0 + kk) * N + n0 + (lane & 31)]; if (kscale) v *= kscale[k0 + kk]; scr[kk * 33 + (lane & 31)] = v; }
    LDS_WAIT(); asm volatile("" ::: "memory");
    const int c = lane & 7;
#pragma unroll
    for (int j = 0; j < 4; ++j) { const int n = (lane >> 3) + 8 * j; const LAS float* s = scr + (8 * c) * 33 + n;
        u32x4 o; o.x = pk2(s[0 * 33], s[1 * 33]); o.y = pk2(s[2 * 33], s[3 * 33]); o.z = pk2(s[4 * 33], s[5 * 33]); o.w = pk2(s[6 * 33], s[7 * 33]);
        const int orow = rbase + (perm ? pg8::perm32(n) : n);
        gst16(WT + (size_t)orow * K + k0 + 8 * c, (u32x4)(o)); }
    LDS_WAIT(); asm volatile("" ::: "memory");
}

struct T8Item { const float* W; unsigned char* WT; int N, K, k0, n0, rbase, perm; const float* kscale; };
__device__ __forceinline__ void t8_load(const T8Item& it, f32x4 (&v)[16], int lane) {
    const int kr = lane >> 3, nq = (lane & 7) * 4;
#pragma unroll
    for (int i = 0; i < 16; ++i) v[i] = __builtin_nontemporal_load((const f32x4*)(it.W + (size_t)(it.k0 + 8 * i + kr) * it.N + it.n0 + nq));
}
__device__ __forceinline__ void t8_finish(const T8Item& it, const f32x4 (&v)[16], float qs, LAS float* scr, int lane) {
    const int kr = lane >> 3, nq = (lane & 7) * 4;
#pragma unroll
    for (int i = 0; i < 16; ++i) { LAS float* d = scr + (8 * i + kr) * 33 + nq; d[0] = v[i].x; d[1] = v[i].y; d[2] = v[i].z; d[3] = v[i].w; }
    LDS_WAIT(); asm volatile("" ::: "memory");
    const int c = lane & 7;
#pragma unroll
    for (int j = 0; j < 4; ++j) { const int n = (lane >> 3) + 8 * j; const LAS float* s = scr + (16 * c) * 33 + n;
        u32x4 o;
#pragma unroll
        for (int q = 0; q < 4; ++q) { f32x4 v = (f32x4){s[(4 * q) * 33], s[(4 * q + 1) * 33], s[(4 * q + 2) * 33], s[(4 * q + 3) * 33]} * qs; if (it.kscale) v = v * *(const f32x4*)(it.kscale + it.k0 + 16 * c + 4 * q); o[q] = pk_fp8x4(v); }
        int orow;
        if (it.perm == 2) { const int a = (it.n0 & 255) + n;
            orow = (it.n0 & ~255) + 128 * ((a >> 3) & 1) + 32 * (a >> 6) + 8 * ((a >> 4) & 3) + (a & 7); }
        else orow = it.rbase + (it.perm ? pg8::perm32(n) : n);
        gst16(it.WT + (size_t)orow * it.K + it.k0 + 16 * c, (u32x4)(o)); }
    LDS_WAIT(); asm volatile("" ::: "memory");
}
constexpr int I_GU8L = 32 * 8 * 64, I_DN8L = 32 * 8 * 32;
__device__ __forceinline__ T8Item t8_item(const Frame& F, int layer, int j) {
    T8Item it;
    if (j < I_GU8L) { const int r = layer * I_GU8L + j, mat = r / (8 * 64), q = r % (8 * 64), kb = q / 64, nb = q % 64, n0 = nb * 32;
        it.W = F.in[20] + (size_t)mat * 1024 * 2048; it.WT = F.ws + WS_WGU + (size_t)mat * 2048 * 1024; it.N = 2048; it.K = 1024; it.k0 = kb * 128; it.n0 = n0;
        it.rbase = ((n0 & 1023) >> 7) * 256 + (n0 >> 10) * 128 + (n0 & 127); it.perm = 0; it.kscale = nullptr; }
    else { const int r = layer * I_DN8L + (j - I_GU8L), mat = r / (8 * 32), q = r % (8 * 32), kb = q / 32, nb = q % 32;
        it.W = F.in[22] + (size_t)mat * 1024 * 1024; it.WT = F.ws + WS_WDN + (size_t)mat * 1024 * 1024; it.N = 1024; it.K = 1024; it.k0 = kb * 128; it.n0 = nb * 32; it.rbase = nb * 32; it.perm = 2; it.kscale = nullptr; }
    return it;
}
__device__ __forceinline__ void convert_experts(Frame& F, int layer, int j0, int j1) {
    const int lane = opq(lane_id());
    LAS float* scr = (LAS float*)(F.lds + F.wave * 16896);
    const int gw = F.vcu * NWAVES + F.wave, NGW = F.G * NWAVES;
    const int NBIG = j1;
    int it = j0 + gw; f32x4 va[16], vb[16]; T8Item ia, ib;
    if (it < NBIG) { ia = t8_item(F, layer, it); t8_load(ia, va, lane); }
    while (it < NBIG) {
        const int itn = it + NGW; if (itn < NBIG) { ib = t8_item(F, layer, itn); t8_load(ib, vb, lane); }
        t8_finish(ia, va, 64.f, scr, lane);
        it = itn; if (it >= NBIG) break;
        const int itn2 = it + NGW; if (itn2 < NBIG) { ia = t8_item(F, layer, itn2); t8_load(ia, va, lane); }
        t8_finish(ib, vb, 64.f, scr, lane);
        it = itn2; }
}

__device__ __forceinline__ void p0_prologue(Frame& F) {
    const float* c_in = F.in[1]; const float* cctx = F.in[3]; const float* ada_w = F.in[4]; const float* ada_b = F.in[5];
    float* modv = (float*)(F.ws + WS_MODV);
    if (F.vcu < 192) {
        LAS float* s = (LAS float*)F.lds;
        { float cv[18];
          const int tq = opq(F.tid);
#pragma unroll
          for (int j = 0; j < 18; ++j) { const int k = (tq + j * NTHR) & 1023; cv[j] = (j >> 1) < 8 ? c_in[(j >> 1) * 1024 + k] : cctx[k]; }
          __builtin_amdgcn_sched_barrier(0);
#pragma unroll
          for (int j = 0; j < 18; ++j) { const float v = cv[j]; s[F.tid + j * NTHR] = v / (1.0f + expf(-v)); } }
        __syncthreads();
        const int ln = opq(F.lane);
        const int col0 = F.vcu * 64, layer = col0 / 6144, nb = col0 % 6144, c16 = ln & 15, kq = ln >> 4;
        const float* wp = ada_w + (size_t)layer * 1024 * 6144 + nb + 4 * c16 + (size_t)(F.wave * 128 + kq) * 6144;
        f32x4 a[9];
#pragma unroll
        for (int b = 0; b < 9; ++b) a[b] = (f32x4){0.f, 0.f, 0.f, 0.f};
        const LAS float* sp = s + F.wave * 128 + kq;
#pragma unroll
        for (int hf = 0; hf < 2; ++hf) { f32x4 w[16];
#pragma unroll
            for (int i = 0; i < 16; ++i) w[i] = __builtin_nontemporal_load((const f32x4*)(wp + (size_t)(4 * (16 * hf + i)) * 6144));
            __builtin_amdgcn_sched_barrier(0);
#pragma unroll
            for (int i = 0; i < 16; ++i) {
#pragma unroll
                for (int b = 0; b < 9; ++b) a[b] += w[i] * sp[b * 1024 + 4 * (16 * hf + i)]; }
            __builtin_amdgcn_sched_barrier(0); }
        LAS float* red = (LAS float*)(F.lds + 40960);
#pragma unroll
        for (int b = 0; b < 9; ++b) *(LAS f32x4*)(red + ((F.wave * 4 + kq) * 9 + b) * 64 + 4 * c16) = a[b];
        __syncthreads();
        for (int i = F.tid; i < 9 * 64; i += NTHR) { const int b = i >> 6, l = i & 63; float t = 0.f;
#pragma unroll
            for (int p = 0; p < 32; ++p) t += red[(p * 9 + b) * 64 + l];
            const int nn = nb + l; modv[((size_t)layer * 9 + b) * 6144 + nn] = t + ada_b[layer * 6144 + nn]; }
        __syncthreads();
    }
    if (F.vcu == 192) {
        f32x2* rope = (f32x2*)(F.ws + WS_ROPE);
        for (int i = F.tid; i < 64 * 16; i += NTHR) { const int p = i >> 4, f = i & 15;
            double invf = 1.0; for (int q = 0; q < f; ++q) invf *= 0.56234132519034908;
            const double x = (double)p * invf, kk = __builtin_rint(x * 0.15915494309189535), r = (x - kk * 6.2831853071795862) , r2 = r * r;
            double sn = 0.0, cs = 0.0, ts = r, tc = 1.0;
#pragma unroll
            for (int n = 0; n < 14; ++n) { sn += ts; cs += tc; tc = -tc * r2 * (1.0 / (double)((2 * n + 1) * (2 * n + 2))); ts = -ts * r2 * (1.0 / (double)((2 * n + 2) * (2 * n + 3))); }
            rope[i] = (f32x2){(float)cs, (float)sn}; }
    }
    if (F.vcu >= 193 && F.vcu < 201) {
        const float* rw = F.in[18]; float* rwt = (float*)(F.ws + WS_RWT); const int g = (F.vcu - 193) * NTHR + opq(F.tid); float v[16];
#pragma unroll
        for (int j = 0; j < 16; ++j) v[j] = rw[g + 4096 * j];
#pragma unroll
        for (int j = 0; j < 16; ++j) { const int i = g + 4096 * j; rwt[(size_t)(i >> 15) * 32768 + (i & 31) * 1024 + ((i >> 5) & 1023)] = v[j]; }
    }
    if (F.vcu >= 201 && F.vcu < 209) {
        u32x4* z = (u32x4*)(F.ws + WS_WP1 + (size_t)832 * 1024);
        for (int i = (F.vcu - 201) * NTHR + F.tid; i < 192 * 64; i += 8 * NTHR) z[i] = (u32x4){0u, 0u, 0u, 0u};
    }
    if (F.vcu <= 192) return;
    LAS float* scr = (LAS float*)(F.lds + F.wave * 16896);
    const int gw = (F.vcu - 193) * NWAVES + F.wave, NGW = (F.G - 193) * NWAVES;
    constexpr int I_POOL = 4 * 4 * 8, I_DQ = 8 * 16, I_DKV = 8 * 10, I_UQ = 4 * 48, I_UKV = 2 * 64, I_WO = 8 * 32;
    constexpr int NITEMS = I_POOL + I_DQ + I_DKV + I_UQ + I_UKV + I_WO;
    for (int it = gw; it < NITEMS; it += NGW) {
        int r = it;
        if (r < I_POOL) { const int g = r / 32, q = r % 32, kb = q / 8, nb = q % 8;
            transpose_item(F.in[8] + (size_t)g * 256 * 256, 256, 256, (bf16_t*)(F.ws + WS_WPOOL) + (size_t)g * 256 * 256, kb * 64, nb * 32, nb * 32, false, nullptr, scr, F.lane); continue; } r -= I_POOL;
        if (r < I_DQ) { const int kb = r / 16, nb = r % 16; f32x4 vv[16];
            T8Item wi; wi.W = F.in[11]; wi.WT = F.ws + WS_WP1; wi.N = 512; wi.K = 1024; wi.k0 = kb * 128; wi.n0 = nb * 32; wi.rbase = nb * 32; wi.perm = 0; wi.kscale = nullptr;
            t8_load(wi, vv, F.lane); t8_finish(wi, vv, 64.f, scr, F.lane); continue; } r -= I_DQ;
        if (r < I_DKV) { const int kb = r / 10, nb = r % 10; f32x4 vv[16];
            T8Item wi; wi.W = F.in[14]; wi.WT = F.ws + WS_WP1; wi.N = 320; wi.K = 1024; wi.k0 = kb * 128; wi.n0 = nb * 32; wi.rbase = 512 + nb * 32; wi.perm = nb >= 8; wi.kscale = nullptr;
            t8_load(wi, vv, F.lane); t8_finish(wi, vv, 64.f, scr, F.lane); continue; } r -= I_DKV;
        if (r < I_UQ) { const int kb = r / 48, nb = r % 48; f32x4 vv[16];
            T8Item wi; wi.W = F.in[13]; wi.WT = F.ws + WS_WUQ; wi.N = 1536; wi.K = 512; wi.k0 = kb * 128; wi.n0 = nb * 32; wi.rbase = nb * 32; wi.perm = (nb % 6) >= 4; wi.kscale = F.in[12];
            t8_load(wi, vv, F.lane); t8_finish(wi, vv, 64.f, scr, F.lane); continue; } r -= I_UQ;
        if (r < I_UKV) { const int kb = r / 64, nb = r % 64; f32x4 vv[16];
            T8Item wi; wi.W = F.in[16]; wi.WT = F.ws + WS_WUKV; wi.N = 2048; wi.K = 256; wi.k0 = kb * 128; wi.n0 = nb * 32; wi.rbase = nb * 32; wi.perm = 0; wi.kscale = F.in[15];
            t8_load(wi, vv, F.lane); t8_finish(wi, vv, 64.f, scr, F.lane); continue; } r -= I_UKV;
        { const int kb = r / 32, nb = r % 32; f32x4 vv[16];
            T8Item wi; wi.W = F.in[17]; wi.WT = F.ws + WS_WO; wi.N = 1024; wi.K = 1024; wi.k0 = kb * 128; wi.n0 = nb * 32; wi.rbase = nb * 32; wi.perm = 0; wi.kscale = nullptr;
            t8_load(wi, vv, F.lane); t8_finish(wi, vv, 64.f, scr, F.lane); }
    }
}

__device__ __forceinline__ const float* xrow_ptr(const Frame& F, int row) { return row < NL ? F.in[0] + (size_t)row * D : F.in[2] + (size_t)(row - NL) * D; }

template <int W> __device__ __forceinline__ f32x4 win_sum(const Frame& F, const LAS float* rinv_l, int rbase, int base, int t, int Lseq, int col, int& cnt) {
    f32x4 v[W]; float w[W]; cnt = 0;
#pragma unroll
    for (int i = 0; i < W; ++i) { const int tt = t - W / 2 + i; const bool ok = tt >= 0 && tt < Lseq; const int tc = tt < 0 ? 0 : (tt >= Lseq ? Lseq - 1 : tt); const int rr = base + tc;
        v[i] = *(const f32x4*)(xrow_ptr(F, rr) + col); w[i] = ok ? rinv_l[rr - rbase] : 0.f; cnt += ok ? 1 : 0; }
    f32x4 s = (f32x4){0.f, 0.f, 0.f, 0.f};
#pragma unroll
    for (int i = 0; i < W; ++i) s += v[i] * w[i];
    return s;
}
__device__ __forceinline__ void p1_pooldiff(Frame& F) {
    const int rpb = (NT + F.G - 1) / F.G, r0 = F.vcu * rpb, r1 = min(NT, r0 + rpb);
    if (r0 >= r1) return;
    const int h0 = max(0, r0 - 8), h1 = min(NT, r1 + 8);
    LAS float* rinv_l = (LAS float*)(F.misc + M_RINV);
    for (int row = h0 + F.wave; row < h1; row += NWAVES) {
        const f32x4* xr = (const f32x4*)xrow_ptr(F, row) + F.lane; float s = 0.f;
#pragma unroll
        for (int j = 0; j < 4; ++j) { const f32x4 v = xr[64 * j]; s += (v.x * v.x + v.y * v.y) + (v.z * v.z + v.w * v.w); }
        s = wave_sum(s);
        if (F.lane == 0) rinv_l[row - h0] = 1.0f / sqrtf(s * (1.0f / D) + EPS);
    }
    __syncthreads();
    const float* ng = F.in[6];
    const float* modv = (const float*)(F.ws + WS_MODV);
    bf16_t* H = (bf16_t*)(F.ws + WS_H);
    const int rpw = (r1 - r0 + NWAVES - 1) / NWAVES, ra = r0 + rpw * F.wave, rb = min(r1, ra + rpw);
    f32x4 S[4] = {{0.f, 0.f, 0.f, 0.f}, {0.f, 0.f, 0.f, 0.f}, {0.f, 0.f, 0.f, 0.f}, {0.f, 0.f, 0.f, 0.f}}; int cnt[4] = {1, 1, 1, 1};
    for (int row = ra; row < rb; ++row) {
        int bidx, t, Lseq;
        if (row < NL) { bidx = row >> 11; t = row & 2047; Lseq = SEQ; } else { bidx = 8; t = (row - NL) & 255; Lseq = CTXL; }
        const int base = row - t; const float* xs = xrow_ptr(F, row);
        const float* s1 = modv + (bidx * 6 + 1) * 1024;
        const float rself = rinv_l[row - h0];
        f32x4 self[4];
#pragma unroll
        for (int j = 0; j < 4; ++j) self[j] = *(const f32x4*)(xs + 256 * j + 4 * F.lane);
        if (row == ra || t == 0) {
            S[0] = win_sum<2>(F, rinv_l, h0, base, t, Lseq, 4 * F.lane, cnt[0]);
            S[1] = win_sum<4>(F, rinv_l, h0, base, t, Lseq, 256 + 4 * F.lane, cnt[1]);
            S[2] = win_sum<8>(F, rinv_l, h0, base, t, Lseq, 512 + 4 * F.lane, cnt[2]);
            S[3] = win_sum<16>(F, rinv_l, h0, base, t, Lseq, 768 + 4 * F.lane, cnt[3]);
        } else {
            f32x4 va[4], vr[4]; float wa[4], wr_[4];
#pragma unroll
            for (int j = 0; j < 4; ++j) { const int hw = 1 << j;
                const int ta = t + hw - 1, tr = t - 1 - hw; const bool oka = ta < Lseq, okr = tr >= 0;
                const int rra = base + (oka ? ta : Lseq - 1), rrr = base + (okr ? tr : 0);
                va[j] = *(const f32x4*)(xrow_ptr(F, rra) + 256 * j + 4 * F.lane); vr[j] = *(const f32x4*)(xrow_ptr(F, rrr) + 256 * j + 4 * F.lane);
                wa[j] = oka ? rinv_l[rra - h0] : 0.f; wr_[j] = okr ? rinv_l[rrr - h0] : 0.f; cnt[j] += (oka ? 1 : 0) - (okr ? 1 : 0); }
#pragma unroll
            for (int j = 0; j < 4; ++j) S[j] += va[j] * wa[j] - vr[j] * wr_[j];
        }
#pragma unroll
        for (int j = 0; j < 4; ++j) { const int col = 256 * j + 4 * F.lane;
            const f32x4 gg = *(const f32x4*)(ng + col) * (*(const f32x4*)(s1 + col) + 1.0f);
            const f32x4 d = (S[j] * (1.0f / (float)cnt[j]) - self[j] * rself) * gg;
            u32x2 w; w.x = pk2(d.x, d.y); w.y = pk2(d.z, d.w);
            *(u32x2*)(H + (size_t)row * D + col) = w; }
    }
}

constexpr int DT_LD = 264, DT_TILE = 72 * DT_LD;
template <int J> __device__ __forceinline__ void pool_group(const Frame& F, const LAS float* rinv_l, int h0, int ra, int rb, int r0, LAS bf16_t* dt, const float* ng, const float* modv, int lane) {
    constexpr int HW = 1 << J, W = 2 * HW, NS = 9 + W - 1;
    const int col = 256 * J + 4 * lane;
    f32x4 xw[NS];
#pragma unroll
    for (int i = 0; i < NS; ++i) { const int rr = ra - HW + i, rc = rr < 0 ? 0 : (rr >= NT ? NT - 1 : rr); xw[i] = *(const f32x4*)(xrow_ptr(F, rc) + col); }
    const int bA = ra < NL ? (ra >> 11) : 8, bB = (rb - 1) < NL ? ((rb - 1) >> 11) : 8;
    const f32x4 ngv = *(const f32x4*)(ng + col);
    const f32x4 ggA = ngv * (*(const f32x4*)(modv + (bA * 6 + 1) * 1024 + col) + 1.0f), ggB = ngv * (*(const f32x4*)(modv + (bB * 6 + 1) * 1024 + col) + 1.0f);
    __builtin_amdgcn_sched_barrier(0);
#pragma unroll
    for (int i = 0; i < NS; ++i) { const int rr = ra - HW + i, rc = rr < 0 ? 0 : (rr >= NT ? NT - 1 : rr); xw[i] = xw[i] * rinv_l[rc - h0]; }
#pragma unroll
    for (int q = 0; q < 9; ++q) { const int r = ra + q;
        if (r < rb) {
            int bidx, t, Lseq;
            if (r < NL) { bidx = r >> 11; t = r & 2047; Lseq = SEQ; } else { bidx = 8; t = (r - NL) & 255; Lseq = CTXL; }
            const int base = r - t, lo = max(base, r - HW), hi = min(base + Lseq, r + HW);
            f32x4 S = (f32x4){0.f, 0.f, 0.f, 0.f};
#pragma unroll
            for (int k = 0; k < W; ++k) { const int rr = r - HW + k; const float m = (rr >= lo && rr < hi) ? 1.0f : 0.0f; S += xw[q + k] * m; }
            const f32x4 d = (S * (1.0f / (float)(hi - lo)) - xw[q + HW]) * (bidx == bA ? ggA : ggB);
            u32x2 w; w.x = pk2(d.x, d.y); w.y = pk2(d.z, d.w);
            *(LAS u32x2*)(dt + J * DT_TILE + (r - r0) * DT_LD + 4 * lane) = w; } }
}
constexpr int XS_LD = 264, DT1_OFF = 46592;
template <int J> __device__ __forceinline__ void pool_group2(Frame& F, bf16_t* X1, const LAS float* rinv_l, int h0, int h1, int r0, int r1) {
    constexpr int HW = 1 << J, W = 2 * HW, NS = 9 + W - 1;
    LAS bf16_t* xs = (LAS bf16_t*)F.lds; LAS bf16_t* dt = (LAS bf16_t*)(F.lds + DT1_OFF);
    const int tid = F.tid, lane = F.lane, n16 = lane & 15, kq = lane >> 4, nr = r1 - r0;
    const float* ng = F.in[6]; const float* pb = F.in[9]; const float* ps = F.in[10];
    const float* modv = (const float*)(F.ws + WS_MODV); const bf16_t* Wp = (const bf16_t*)(F.ws + WS_WPOOL);
    f32x4 sv[11];
#pragma unroll
    for (int i = 0; i < 11; ++i) { const int c = tid + NTHR * i, row = c >> 6, cq = c & 63, gr = min(h0 + row, h1 - 1); sv[i] = *(const f32x4*)(xrow_ptr(F, gr) + 256 * J + 4 * cq); }
    const int ra = r0 + 9 * F.wave, rb = min(r1, ra + 9);
    const int rbm = rb > ra ? rb - 1 : ra, bA = ra < NL ? (ra >> 11) : 8, bB = rbm < NL ? (rbm >> 11) : 8;
    const int wcol = 256 * J + 4 * lane;
    const f32x4 ngv = *(const f32x4*)(ng + wcol);
    const f32x4 ggA = ngv * (*(const f32x4*)(modv + (bA * 6 + 1) * 1024 + wcol) + 1.0f), ggB = ngv * (*(const f32x4*)(modv + (bB * 6 + 1) * 1024 + wcol) + 1.0f);
    __builtin_amdgcn_sched_barrier(0);
#pragma unroll
    for (int i = 0; i < 11; ++i) { const int c = tid + NTHR * i, row = c >> 6, cq = c & 63; u32x2 w; w.x = pk2(sv[i].x, sv[i].y); w.y = pk2(sv[i].z, sv[i].w); *(LAS u32x2*)(xs + row * XS_LD + 4 * cq) = w; }
    __syncthreads();
    if (ra < rb) {
        f32x4 xw[NS];
#pragma unroll
        for (int i = 0; i < NS; ++i) { const int rr = ra - HW + i, li = (rr < h0 ? h0 : (rr >= h1 ? h1 - 1 : rr)) - h0; const u32x2 w = *(const LAS u32x2*)(xs + li * XS_LD + 4 * lane);
            xw[i] = (f32x4){bf_lo(w.x), bf_hi(w.x), bf_lo(w.y), bf_hi(w.y)} * rinv_l[li]; }
#pragma unroll
        for (int q = 0; q < 9; ++q) { const int r = ra + q;
            if (r < rb) {
                int bidx, t, Lseq;
                if (r < NL) { bidx = r >> 11; t = r & 2047; Lseq = SEQ; } else { bidx = 8; t = (r - NL) & 255; Lseq = CTXL; }
                const int base = r - t, lo = max(base, r - HW), hi = min(base + Lseq, r + HW);
                f32x4 S = (f32x4){0.f, 0.f, 0.f, 0.f};
#pragma unroll
                for (int k = 0; k < W; ++k) { const int rr = r - HW + k; const float m = (rr >= lo && rr < hi) ? 1.0f : 0.0f; S += xw[q + k] * m; }
                const f32x4 d = (S * (1.0f / (float)(hi - lo)) - xw[q + HW]) * (bidx == bA ? ggA : ggB);
                u32x2 w; w.x = pk2(d.x, d.y); w.y = pk2(d.z, d.w);
                *(LAS u32x2*)(dt + (r - r0) * XS_LD + 4 * lane) = w; } } }
    bf16x8 af[8][2];
    { const bf16_t* wa = Wp + (size_t)J * 256 * 256 + (size_t)(F.wave * 32 + n16) * 256 + kq * 8;
#pragma unroll
      for (int ks = 0; ks < 8; ++ks) { af[ks][0] = *(const bf16x8*)(wa + ks * 32); af[ks][1] = *(const bf16x8*)(wa + 16 * 256 + ks * 32); } }
    f32x4 g1v[5][2];
#pragma unroll
    for (int tt = 0; tt < 5; ++tt) { const int tok = min(tt * 16 + n16, nr - 1), row = r0 + tok, bidx = row < NL ? (row >> 11) : 8;
#pragma unroll
        for (int nt = 0; nt < 2; ++nt) g1v[tt][nt] = *(const f32x4*)(modv + (bidx * 6 + 2) * 1024 + 256 * J + F.wave * 32 + nt * 16 + 4 * kq); }
    __syncthreads();
    f32x4 acc[5][2];
#pragma unroll
    for (int tt = 0; tt < 5; ++tt) { acc[tt][0] = (f32x4){0.f, 0.f, 0.f, 0.f}; acc[tt][1] = acc[tt][0]; }
    const LAS bf16_t* db = dt + n16 * XS_LD + kq * 8;
#pragma unroll
    for (int ks = 0; ks < 8; ++ks) {
#pragma unroll
        for (int tt = 0; tt < 5; ++tt) { const bf16x8 b = *(const LAS bf16x8*)(db + tt * 16 * XS_LD + ks * 32);
            acc[tt][0] = __builtin_amdgcn_mfma_f32_16x16x32_bf16(af[ks][0], b, acc[tt][0], 0, 0, 0); acc[tt][1] = __builtin_amdgcn_mfma_f32_16x16x32_bf16(af[ks][1], b, acc[tt][1], 0, 0, 0); } }
#pragma unroll
    for (int nt = 0; nt < 2; ++nt) { const int cl = F.wave * 32 + nt * 16 + 4 * kq, c = 256 * J + cl; const f32x4 bv = *(const f32x4*)(pb + c), sc = *(const f32x4*)(ps + c);
#pragma unroll
        for (int tt = 0; tt < 5; ++tt) { const int tok = tt * 16 + n16;
            if (tok < nr) { const u32x2 xw_ = *(const LAS u32x2*)(xs + (r0 - h0 + tok) * XS_LD + cl);
                const f32x4 x1 = (f32x4){bf_lo(xw_.x), bf_hi(xw_.x), bf_lo(xw_.y), bf_hi(xw_.y)} + (acc[tt][nt] + bv) * sc * g1v[tt][nt];
                u32x2 w; w.x = pk2(x1.x, x1.y); w.y = pk2(x1.z, x1.w); *(u32x2*)(X1 + (size_t)(r0 + tok) * D + c) = w; } } }
    __syncthreads();
}
__device__ __forceinline__ void pool_block2(Frame& F, bf16_t* X1) {
    const int rpb = (NT + F.G - 1) / F.G, r0 = F.vcu * rpb, r1 = min(NT, r0 + rpb), nr = r1 - r0;
    if (nr <= 0) return;
    const int h0 = max(0, r0 - 8), h1 = min(NT, r1 + 8);
    LAS float* rinv_l = (LAS float*)(F.misc + M_RINV);
    for (int rb = h0 + F.wave; rb < h1; rb += 6 * NWAVES) {
        f32x4 v[6][4];
#pragma unroll
        for (int q = 0; q < 6; ++q) { const int row = min(rb + q * NWAVES, h1 - 1); const f32x4* xr = (const f32x4*)xrow_ptr(F, row) + F.lane;
#pragma unroll
            for (int j = 0; j < 4; ++j) v[q][j] = xr[64 * j]; }
        __builtin_amdgcn_sched_barrier(0);
#pragma unroll
        for (int q = 0; q < 6; ++q) { const int row = rb + q * NWAVES; float s = 0.f;
#pragma unroll
            for (int j = 0; j < 4; ++j) s += (v[q][j].x * v[q][j].x + v[q][j].y * v[q][j].y) + (v[q][j].z * v[q][j].z + v[q][j].w * v[q][j].w);
            s = wave_sum(s);
            if (row < h1 && F.lane == 0) rinv_l[row - h0] = 1.0f / sqrtf(s * (1.0f / D) + EPS); }
    }
    __syncthreads();
    pool_group2<0>(F, X1, rinv_l, h0, h1, r0, r1); pool_group2<1>(F, X1, rinv_l, h0, h1, r0, r1); pool_group2<2>(F, X1, rinv_l, h0, h1, r0, r1); pool_group2<3>(F, X1, rinv_l, h0, h1, r0, r1);
    VM_WAIT(); __syncthreads();
}
__device__ __forceinline__ void pool_block(Frame& F, bf16_t* X1) {
    const int rpb = (NT + F.G - 1) / F.G, r0 = F.vcu * rpb, r1 = min(NT, r0 + rpb), nr = r1 - r0;
    if (nr <= 0) return;
    const int h0 = max(0, r0 - 8), h1 = min(NT, r1 + 8);
    LAS float* rinv_l = (LAS float*)(F.misc + M_RINV);
    LAS bf16_t* dt = (LAS bf16_t*)F.lds;
    for (int rb = h0 + F.wave; rb < h1; rb += 6 * NWAVES) {
        f32x4 v[6][4];
#pragma unroll
        for (int q = 0; q < 6; ++q) { const int row = min(rb + q * NWAVES, h1 - 1); const f32x4* xr = (const f32x4*)xrow_ptr(F, row) + F.lane;
#pragma unroll
            for (int j = 0; j < 4; ++j) v[q][j] = xr[64 * j]; }
        __builtin_amdgcn_sched_barrier(0);
#pragma unroll
        for (int q = 0; q < 6; ++q) { const int row = rb + q * NWAVES; float s = 0.f;
#pragma unroll
            for (int j = 0; j < 4; ++j) s += (v[q][j].x * v[q][j].x + v[q][j].y * v[q][j].y) + (v[q][j].z * v[q][j].z + v[q][j].w * v[q][j].w);
            s = wave_sum(s);
            if (row < h1 && F.lane == 0) rinv_l[row - h0] = 1.0f / sqrtf(s * (1.0f / D) + EPS); }
    }
    __syncthreads();
    const float* ng = F.in[6]; const float* pb = F.in[9]; const float* ps = F.in[10];
    const float* modv = (const float*)(F.ws + WS_MODV);
    const bf16_t* Wp = (const bf16_t*)(F.ws + WS_WPOOL);
    const int lane = F.lane, n16 = lane & 15, kq = lane >> 4;
    { const int rpw = (nr + NWAVES - 1) / NWAVES, ra = r0 + rpw * F.wave, rb = min(r1, ra + rpw);
      if (ra < rb) {
        pool_group<0>(F, rinv_l, h0, ra, rb, r0, dt, ng, modv, lane); pool_group<1>(F, rinv_l, h0, ra, rb, r0, dt, ng, modv, lane);
        pool_group<2>(F, rinv_l, h0, ra, rb, r0, dt, ng, modv, lane); pool_group<3>(F, rinv_l, h0, ra, rb, r0, dt, ng, modv, lane); } }
    __syncthreads();
#pragma nounroll
    for (int g = 0; g < 4; ++g) {
        bf16x8 af[8][2];
        { const bf16_t* wa = Wp + (size_t)g * 256 * 256 + (size_t)(F.wave * 32 + n16) * 256 + kq * 8;
#pragma unroll
          for (int ks = 0; ks < 8; ++ks) { af[ks][0] = *(const bf16x8*)(wa + ks * 32); af[ks][1] = *(const bf16x8*)(wa + 16 * 256 + ks * 32); } }
        f32x4 xin[5][2], g1v[5][2];
#pragma unroll
        for (int tt = 0; tt < 5; ++tt) { const int tok = min(tt * 16 + n16, nr - 1), row = r0 + tok, bidx = row < NL ? (row >> 11) : 8;
#pragma unroll
            for (int nt = 0; nt < 2; ++nt) { const int c = 256 * g + F.wave * 32 + nt * 16 + 4 * kq; xin[tt][nt] = *(const f32x4*)(xrow_ptr(F, row) + c); g1v[tt][nt] = *(const f32x4*)(modv + (bidx * 6 + 2) * 1024 + c); } }
        __builtin_amdgcn_sched_barrier(0);
        f32x4 acc[5][2];
#pragma unroll
        for (int tt = 0; tt < 5; ++tt) { acc[tt][0] = (f32x4){0.f, 0.f, 0.f, 0.f}; acc[tt][1] = acc[tt][0]; }
        const LAS bf16_t* db = dt + g * DT_TILE + n16 * DT_LD + kq * 8;
#pragma unroll
        for (int ks = 0; ks < 8; ++ks) {
#pragma unroll
            for (int tt = 0; tt < 5; ++tt) { const bf16x8 b = *(const LAS bf16x8*)(db + tt * 16 * DT_LD + ks * 32);
                acc[tt][0] = __builtin_amdgcn_mfma_f32_16x16x32_bf16(af[ks][0], b, acc[tt][0], 0, 0, 0); acc[tt][1] = __builtin_amdgcn_mfma_f32_16x16x32_bf16(af[ks][1], b, acc[tt][1], 0, 0, 0); } }
#pragma unroll
        for (int nt = 0; nt < 2; ++nt) { const int c = 256 * g + F.wave * 32 + nt * 16 + 4 * kq; const f32x4 bv = *(const f32x4*)(pb + c), sv = *(const f32x4*)(ps + c);
#pragma unroll
            for (int tt = 0; tt < 5; ++tt) { const int tok = tt * 16 + n16;
                if (tok < nr) { const f32x4 x1 = xin[tt][nt] + (acc[tt][nt] + bv) * sv * g1v[tt][nt];
                    u32x2 w; w.x = pk2(x1.x, x1.y); w.y = pk2(x1.z, x1.w); *(u32x2*)(X1 + (size_t)(r0 + tok) * D + c) = w; } } }
    }
    VM_WAIT(); __syncthreads();
}

constexpr int RW_LD = 1032;
__device__ __forceinline__ void route_phase(Frame& F, const bf16_t* xin, int nrows, int layer, int cl) {
    const int rpb = (nrows + F.G - 1) / F.G, r0 = F.vcu * rpb, r1 = min(nrows, r0 + rpb), nr = r1 > r0 ? r1 - r0 : 0;
    const float* rwt = (const float*)(F.ws + WS_RWT) + (size_t)layer * 32 * 1024;
    LAS bf16_t* rwb = (LAS bf16_t*)F.lds;
    LAS float* lg = (LAS float*)(F.lds + 32 * RW_LD * 2);
    { f32x4 wv[16];
#pragma unroll
      for (int k = 0; k < 16; ++k) wv[k] = ((const f32x4*)rwt)[F.tid + k * NTHR];
#pragma unroll
      for (int k = 0; k < 16; ++k) { const int i = F.tid + k * NTHR, e = i >> 8, c = (i & 255) * 4; u32x2 p; p.x = pk2(wv[k].x, wv[k].y); p.y = pk2(wv[k].z, wv[k].w); *(LAS u32x2*)(rwb + e * RW_LD + c) = p; } }
    LAS int* lcnt = (LAS int*)(F.misc + M_LCNT); LAS int* lbase = (LAS int*)(F.misc + M_LBASE);
    if (F.tid < 32) lcnt[F.tid] = 0;
    const float* ng = F.in[7] + layer * 1024; const float* rb = F.in[19] + layer * 32;
    const float* modv = (const float*)(F.ws + WS_MODV) + (size_t)layer * 9 * 6144;
    unsigned char* H8 = F.ws + WS_H8;
    LAS bf16_t* ht = (LAS bf16_t*)(F.lds + 32 * RW_LD * 2 + 80 * 33 * 4);
    const int lane = F.lane;
    __syncthreads();
    for (int c0r = 0; c0r < nr; c0r += 32) {
        const int cend = min(c0r + 32, nr);
        for (int rl = c0r + F.wave; rl < cend; rl += 2 * NWAVES) {
            const int rlb = rl + NWAVES; const bool hasb = rlb < cend; const int row = r0 + rl, rowb = r0 + rlb, rb_ = hasb ? rowb : row;
            const u32x2* xa = (const u32x2*)(xin + (size_t)row * D) + lane; const u32x2* xb = (const u32x2*)(xin + (size_t)rb_ * D) + lane;
            f32x4 va[4], vb[4]; float sa = 0.f, sb = 0.f;
#pragma unroll
            for (int j = 0; j < 4; ++j) { const u32x2 wa = xa[64 * j], wb = xb[64 * j]; va[j] = (f32x4){bf_lo(wa.x), bf_hi(wa.x), bf_lo(wa.y), bf_hi(wa.y)}; vb[j] = (f32x4){bf_lo(wb.x), bf_hi(wb.x), bf_lo(wb.y), bf_hi(wb.y)}; }
#pragma unroll
            for (int j = 0; j < 4; ++j) { sa += (va[j].x * va[j].x + va[j].y * va[j].y) + (va[j].z * va[j].z + va[j].w * va[j].w); sb += (vb[j].x * vb[j].x + vb[j].y * vb[j].y) + (vb[j].z * vb[j].z + vb[j].w * vb[j].w); }
            const float ra = 1.0f / sqrtf(wave_sum(sa) * (1.0f / D) + EPS), rbv = 1.0f / sqrtf(wave_sum(sb) * (1.0f / D) + EPS);
            const int bia = row < NL ? (row >> 11) : 8, bib = rb_ < NL ? (rb_ >> 11) : 8;
#pragma unroll
            for (int j = 0; j < 4; ++j) { const int col = 256 * j + 4 * lane; const f32x4 g = *(const f32x4*)(ng + col);
                const f32x4 ha = va[j] * ra * g * (*(const f32x4*)(modv + (bia * 6 + 4) * 1024 + col) + 1.0f) + *(const f32x4*)(modv + (bia * 6 + 3) * 1024 + col);
                *(unsigned*)(H8 + (size_t)row * D + col) = pk_fp8x4(ha * 8.0f);
                u32x2 w; w.x = pk2(ha.x, ha.y); w.y = pk2(ha.z, ha.w); *(LAS u32x2*)(ht + (rl - c0r) * RW_LD + col) = w;
                if (hasb) { const f32x4 hb = vb[j] * rbv * g * (*(const f32x4*)(modv + (bib * 6 + 4) * 1024 + col) + 1.0f) + *(const f32x4*)(modv + (bib * 6 + 3) * 1024 + col);
                    *(unsigned*)(H8 + (size_t)rowb * D + col) = pk_fp8x4(hb * 8.0f);
                    u32x2 w2; w2.x = pk2(hb.x, hb.y); w2.y = pk2(hb.z, hb.w); *(LAS u32x2*)(ht + (rlb - c0r) * RW_LD + col) = w2; } }
        }
        __syncthreads();
        if (F.wave < 2 && c0r + F.wave * 16 < nr) {
            const int n = lane & 15, kq = lane >> 4;
            const LAS bf16_t* hp = ht + (F.wave * 16 + n) * RW_LD + kq * 8; const LAS bf16_t* wp = rwb + n * RW_LD + kq * 8;
            f32x4 c0 = (f32x4){0.f, 0.f, 0.f, 0.f}, c1 = c0;
#pragma unroll 8
            for (int ks = 0; ks < 32; ++ks) { const bf16x8 b = *(const LAS bf16x8*)(hp + ks * 32);
                const bf16x8 a0 = *(const LAS bf16x8*)(wp + ks * 32), a1 = *(const LAS bf16x8*)(wp + 16 * RW_LD + ks * 32);
                c0 = __builtin_amdgcn_mfma_f32_16x16x32_bf16(a0, b, c0, 0, 0, 0); c1 = __builtin_amdgcn_mfma_f32_16x16x32_bf16(a1, b, c1, 0, 0, 0); }
            LAS float* lr = lg + (c0r + F.wave * 16 + n) * 33 + 4 * kq;
#pragma unroll
            for (int j = 0; j < 4; ++j) { lr[j] = c0[j] + rb[4 * kq + j]; lr[16 + j] = c1[j] + rb[16 + 4 * kq + j]; }
        }
        __syncthreads();
    }
    int te[4] = {0, 0, 0, 0}, lp[4] = {0, 0, 0, 0}; float tg[4] = {0.f, 0.f, 0.f, 0.f};
    if (F.tid < nr) { const LAS float* l = lg + F.tid * 33; float tv[4] = {-3.0e38f, -3.0e38f, -3.0e38f, -3.0e38f};
#pragma unroll 4
        for (int e = 0; e < 32; ++e) { const float v = l[e];
            if (v > tv[3]) { if (v > tv[0]) { tv[3] = tv[2]; te[3] = te[2]; tv[2] = tv[1]; te[2] = te[1]; tv[1] = tv[0]; te[1] = te[0]; tv[0] = v; te[0] = e; }
                else if (v > tv[1]) { tv[3] = tv[2]; te[3] = te[2]; tv[2] = tv[1]; te[2] = te[1]; tv[1] = v; te[1] = e; }
                else if (v > tv[2]) { tv[3] = tv[2]; te[3] = te[2]; tv[2] = v; te[2] = e; }
                else { tv[3] = v; te[3] = e; } } }
        const float e1 = expf(tv[1] - tv[0]), e2 = expf(tv[2] - tv[0]), e3 = expf(tv[3] - tv[0]), inv = 1.0f / (1.0f + e1 + e2 + e3);
        tg[0] = inv; tg[1] = e1 * inv; tg[2] = e2 * inv; tg[3] = e3 * inv;
#pragma unroll
        for (int k = 0; k < 4; ++k) lp[k] = __hip_atomic_fetch_add(lcnt + te[k], 1, __ATOMIC_RELAXED, __HIP_MEMORY_SCOPE_WORKGROUP); }
    __syncthreads();
    if (F.tid < 32) { const int c = lcnt[F.tid]; lbase[F.tid] = c ? (int)__hip_atomic_fetch_add(F.ctl + CW_GCOUNT + (cl * 32 + F.tid) * 64, (unsigned)c, __ATOMIC_RELAXED, __HIP_MEMORY_SCOPE_AGENT) : 0; }
    __syncthreads();
    if (F.tid < nr) { const int row = r0 + F.tid; float* gate = (float*)(F.ws + WS_ROUTE + (size_t)NT * 16); int* slot_aid = (int*)(F.ws + WS_SLOTAID + (cl >= 2 ? 8 * MiB : 0)); int* slot_tok = (int*)(F.ws + WS_SLOTTOK + (cl >= 2 ? 8 * MiB : 0));
        gst16(gate + (size_t)row * 4, (f32x4)((f32x4){tg[0], tg[1], tg[2], tg[3]}));
#pragma unroll
        for (int k = 0; k < 4; ++k) { const size_t p = (size_t)te[k] * NT + lbase[te[k]] + lp[k]; slot_aid[p] = row * 4 + k; slot_tok[p] = row; } }
    __syncthreads();
}

__device__ __forceinline__ int moe_build(Frame& F, int layer, int ntn, bool gather, const float* bias_g) {
    LAS int* tstart = (LAS int*)(F.misc + M_TSTART); LAS int* gcnt = (LAS int*)(F.misc + M_GCNT); LAS int* tab = (LAS int*)(F.misc + M_TAB);
    __syncthreads();
    if (F.tid < 32) gcnt[F.tid] = (int)F.ctl[CW_GCOUNT + (layer * 32 + F.tid) * 64];
    __syncthreads();
    if (F.tid == 0) { int t = 0; for (int e = 0; e < 32; ++e) { tstart[e] = t; t += (gcnt[e] + 255) >> 8; } tstart[32] = t;
        const int U = t * ntn; int n = 0;
        for (int i = 0; i < 16; ++i) { const int L = i * F.G + (int)blockIdx.x; if (L >= U) break; const int wgid = pg8::xcd_remap(L, U);
            int e = 0; while (tstart[e + 1] * ntn <= wgid) ++e;
            const int loc = wgid - tstart[e] * ntn, mt = loc / ntn; const int nv = gcnt[e] - mt * 256;
            tab[8 * n] = tstart[e] + mt; tab[8 * n + 1] = loc % ntn; tab[8 * n + 2] = e; tab[8 * n + 3] = mt; tab[8 * n + 4] = nv < 256 ? nv : 256; ++n; }
        tab[8 * 16] = n; }
    __syncthreads();
    const int n = tab[8 * 16];
    LAS int* rowl = (LAS int*)(F.lds + TOK_OFF); LAS float* biasl = (LAS float*)(F.lds + BIAS_OFF);
    const int* src = (const int*)(F.ws + (gather ? WS_SLOTTOK : WS_SLOTAID));
    for (int i = F.tid; i < n * 256; i += NTHR) { const int u = i >> 8, r = i & 255, e = tab[8 * u + 2], mt = tab[8 * u + 3], nv = tab[8 * u + 4], pn = tab[8 * u + 1];
        rowl[i] = r < nv ? src[(size_t)e * NT + mt * 256 + r] : (gather ? 0 : -1);
        biasl[i] = gather ? bias_g[(size_t)e * 2048 + (r >> 7) * 1024 + pn * 128 + (r & 127)] : bias_g[(size_t)e * 1024 + pn * 256 + r]; }
    __syncthreads();
    return n;
}

struct CombRow { f32x4 x[4]; u32x2 y[4][2]; f32x4 gt; };
__device__ __forceinline__ void comb_load(CombRow& r, const bf16_t* xi, const unsigned char* YS, const float* gate, int row, int lane) {
    const bf16_t* xp = xi + (size_t)row * D + 8 * lane;
    unpk8(*(const u32x4*)(xp), r.x[0], r.x[1]); unpk8(*(const u32x4*)(xp + 512), r.x[2], r.x[3]);
    r.gt = *(const f32x4*)(gate + (size_t)row * 4);
#pragma unroll
    for (int k = 0; k < 4; ++k) { const unsigned char* yp = YS + ((size_t)row * 4 + k) * D + 8 * lane; r.y[k][0] = *(const u32x2*)(yp); r.y[k][1] = *(const u32x2*)(yp + 512); }
}
template <int MODE> __device__ __forceinline__ void comb_finish(Frame& F, CombRow& r, void* xo_, int row, int layer, int lane) {
    const float* modv = (const float*)(F.ws + WS_MODV); bf16_t* H = (bf16_t*)(F.ws + WS_H);
    const int bidx = row < NL ? (row >> 11) : 8;
    const float* g2 = modv + ((size_t)layer * 9 + bidx) * 6144 + 5 * 1024;
    float ss = 0.f;
#pragma unroll
    for (int hh = 0; hh < 2; ++hh) { f32x4 y0 = (f32x4){0.f, 0.f, 0.f, 0.f}, y1 = y0;
#pragma unroll
        for (int k = 0; k < 4; ++k) { const u32x2 w = r.y[k][hh]; const float gk = r.gt[k] * (1.0f / 16.0f);
            const f32x2 a = __builtin_amdgcn_cvt_pk_f32_fp8((int)w.x, false), b = __builtin_amdgcn_cvt_pk_f32_fp8((int)w.x, true);
            const f32x2 c = __builtin_amdgcn_cvt_pk_f32_fp8((int)w.y, false), d = __builtin_amdgcn_cvt_pk_f32_fp8((int)w.y, true);
            y0.x += gk * a.x; y0.y += gk * a.y; y0.z += gk * b.x; y0.w += gk * b.y;
            y1.x += gk * c.x; y1.y += gk * c.y; y1.z += gk * d.x; y1.w += gk * d.y; }
        const int col = 512 * hh + 8 * lane;
        r.x[2 * hh] = r.x[2 * hh] + *(const f32x4*)(g2 + col) * y0; r.x[2 * hh + 1] = r.x[2 * hh + 1] + *(const f32x4*)(g2 + col + 4) * y1; }
#pragma unroll
    for (int i = 0; i < 4; ++i) ss += (r.x[i].x * r.x[i].x + r.x[i].y * r.x[i].y) + (r.x[i].z * r.x[i].z + r.x[i].w * r.x[i].w);
    const float rinv = 1.0f / sqrtf(wave_sum(ss) * (1.0f / D) + EPS);
    if (MODE == 0) {
        const float* ng = F.in[6] + 1024; const float* sh1 = modv + ((size_t)9 + bidx) * 6144; const float* s1 = sh1 + 1024;
#pragma unroll
        for (int hh = 0; hh < 2; ++hh) { const int col = 512 * hh + 8 * lane;
            *(u32x4*)((bf16_t*)xo_ + (size_t)row * D + col) = pk8(r.x[2 * hh], r.x[2 * hh + 1]);
            const f32x4 h0 = r.x[2 * hh] * rinv * *(const f32x4*)(ng + col) * (*(const f32x4*)(s1 + col) + 1.0f) + *(const f32x4*)(sh1 + col);
            const f32x4 h1 = r.x[2 * hh + 1] * rinv * *(const f32x4*)(ng + col + 4) * (*(const f32x4*)(s1 + col + 4) + 1.0f) + *(const f32x4*)(sh1 + col + 4);
            *(u32x2*)(F.ws + WS_H8 + (size_t)row * D + col) = pk_fp8x8(h0, h1, 8.0f); }
    } else {
        const float* fg = F.in[24];
#pragma unroll
        for (int hh = 0; hh < 2; ++hh) { const int col = 512 * hh + 8 * lane; float* xop = (float*)xo_ + (size_t)row * D + col;
            gst16(xop, (f32x4)(r.x[2 * hh] * rinv * *(const f32x4*)(fg + col))); gst16(xop + 4, (f32x4)(r.x[2 * hh + 1] * rinv * *(const f32x4*)(fg + col + 4))); }
    }
}
template <int MODE> __device__ __forceinline__ void combine_phase(Frame& F, const bf16_t* xi, void* xo, int nrows, int layer) {
    const int rpb = (nrows + F.G - 1) / F.G, r0 = F.vcu * rpb, r1 = min(nrows, r0 + rpb);
    const float* gate = (const float*)(F.ws + WS_ROUTE + (size_t)NT * 16); const unsigned char* YS = F.ws + WS_YS;
    const int lane = F.lane;
    for (int row = r0 + F.wave; row < r1; row += 2 * NWAVES) {
        const int rowb = row + NWAVES; const bool hasb = rowb < r1;
        CombRow ra, rb; comb_load(ra, xi, YS, gate, row, lane); comb_load(rb, xi, YS, gate, hasb ? rowb : row, lane);
        comb_finish<MODE>(F, ra, xo, row, layer, lane);
        if (hasb) comb_finish<MODE>(F, rb, xo, rowb, layer, lane);
    }
}

__device__ __forceinline__ int proj2_build(Frame& F) {
    LAS int* tab = (LAS int*)(F.misc + M_TAB);
    __syncthreads();
    if (F.tid == 0) { const int c = (int)blockIdx.x; int n = 0;
        const unsigned long long aK = (unsigned long long)(F.ws + WS_H8), aQ = (unsigned long long)(F.ws + WS_QA), aV = (unsigned long long)(F.ws + WS_CKV);
        const unsigned long long bK = (unsigned long long)(F.ws + WS_WP1) + (unsigned long long)768 * 1024, bQ = (unsigned long long)(F.ws + WS_WUQ), bV = (unsigned long long)(F.ws + WS_WUKV);
#define P2_PUT(ty_, pm_, pn_, nt_, ab_, bb_) do { const unsigned long long tile_ = (unsigned long long)256 * 128 * (nt_); const unsigned long long pa_ = (ab_) + (pm_) * tile_, pb_ = (bb_) + (pn_) * tile_; \
        tab[8 * n] = (pm_); tab[8 * n + 1] = (pn_); tab[8 * n + 2] = (ty_); tab[8 * n + 3] = (nt_); tab[8 * n + 4] = (int)(unsigned)pa_; tab[8 * n + 5] = (int)(unsigned)(pa_ >> 32); \
        tab[8 * n + 6] = (int)(unsigned)pb_; tab[8 * n + 7] = (int)(unsigned)(pb_ >> 32); ++n; } while (0)
#define P2_KPE(i_) P2_PUT(0, (i_), 0, 8, aK, bK)
#define P2_UQ(i_)  P2_PUT(1, (i_) / 6, (i_) % 6, 4, aQ, bQ)
#define P2_UKV(i_) P2_PUT(2, (i_) / 8, (i_) % 8, 2, aV, bV)
        if (c < 16) { P2_KPE(c); P2_UQ(368 + c); }
        else if (c < 72) { P2_KPE(c); P2_UKV(2 * (c - 16)); P2_UKV(2 * (c - 16) + 1); }
        else { P2_UQ(2 * (c - 72)); P2_UQ(2 * (c - 72) + 1); P2_UKV(112 + 2 * (c - 72)); P2_UKV(112 + 2 * (c - 72) + 1); }
        if (c >= 16 && c < 112) P2_UKV(480 + c - 16);
#undef P2_KPE
#undef P2_PUT
#undef P2_UQ
#undef P2_UKV
        tab[8 * 16] = n; }
    __syncthreads();
    const int n = tab[8 * 16];
    { LAS float* rinvl = (LAS float*)(F.lds + TOK_OFF); const float* ssq = (const float*)(F.ws + WS_SSQ);
      for (int i = F.tid; i < n * 256; i += NTHR) { const int u = i >> 8, r = i & 255, row = tab[8 * u] * 256 + r, ty = tab[8 * u + 2]; float sm = 0.f;
          if (ty == 1) {
#pragma unroll
              for (int p = 0; p < 8; ++p) sm += ssq[(size_t)p * NT + row];
              rinvl[i] = (1.0f / 512.0f) / sqrtf(sm * (1.0f / QLORA) + EPS); }
          else {
#pragma unroll
              for (int p = 8; p < 12; ++p) sm += ssq[(size_t)p * NT + row];
              rinvl[i] = (1.0f / 512.0f) / sqrtf(sm * (1.0f / KVLORA) + EPS); } }
      __syncthreads(); }
    return n;
}

constexpr int NPHASE = 15;
__global__ void __launch_bounds__(NTHR, 2) trunk_fwd(Args args) {
    extern __shared__ __attribute__((aligned(16))) unsigned char lds_raw[];
    Frame F;
    F.lds = (LAS unsigned char*)lds_raw; F.misc = F.lds + MISC_OFF;
    F.tid = threadIdx.x; F.lane = F.tid & 63; F.wave = __builtin_amdgcn_readfirstlane(F.tid >> 6);
    F.G = gridDim.x; { const int bx = blockIdx.x; F.vcu = (F.G % 8 == 0) ? (bx % 8) * (F.G / 8) + bx / 8 : bx; }
    F.ws = args.ws; F.ctl = (unsigned*)(args.ws + WS_CTL); F.out = args.out;
#pragma unroll
    for (int i = 0; i < 25; ++i) F.in[i] = args.in[i];
    if (F.tid < 4) ((LAS unsigned*)(F.misc + M_BAR))[F.tid] = 0u;
    __syncthreads();
    XcdBarrier bar; bar.bar = F.ctl + CW_BAR; bar.x = 0; bar.st = nullptr;
#if !MK_PER_PHASE
    bar = xcd_barrier_post(F.ctl + CW_BAR, (volatile LAS unsigned*)(F.misc + M_BAR));
#endif
    const int lo = args.ph_lo, hi = args.ph_hi;
#ifndef PH_MASK
#define PH_MASK 0xFFFFFFFFu
#endif
#define IN(k) (((PH_MASK >> (k)) & 1u) && lo <= (k) && (k) < hi && ((F.lane = opq(lane_id())), (F.tid = F.wave * 64 + F.lane), true))
#if MK_PER_PHASE
#define SEAM(k) do { } while (0)
#else
#ifndef PROBE_XBAR
#define PROBE_XBAR 0
#endif
#define SEAM(k) do { if (IN((k) + 1)) { for (int xb_ = 0; xb_ <= PROBE_XBAR; ++xb_) xcd_barrier(bar, F.wave == 0 && lane_id() == 0); } } while (0)
#endif
    bf16_t* X1 = (bf16_t*)(F.ws + WS_X1); bf16_t* X2 = (bf16_t*)(F.ws + WS_X2); bf16_t* X3 = (bf16_t*)(F.ws + WS_X3);
    const float* modv = (const float*)(F.ws + WS_MODV);
    const f32x2* rope = (const f32x2*)(F.ws + WS_ROPE);
    float* ssq = (float*)(F.ws + WS_SSQ);
    bf16_t* Hb = (bf16_t*)(F.ws + WS_H);

    if (IN(0)) { REPEAT(0) { p0_prologue(F); } SEAM(0); }
    if (IN(1)) { const int cslot = F.vcu % 3;
        if (cslot == 0) { REPEAT(16) { convert_experts(F, 0, 0, I_GU8L); __syncthreads(); } }
        pool_block2(F, X1);
#ifdef PROBE_POOL
        __syncthreads(); pool_block2(F, X1);
#endif
        if (cslot == 1) { REPEAT(16) { convert_experts(F, 0, 0, I_GU8L); __syncthreads(); } }
        REPEAT(2) { route_phase(F, X1, NT, 0, (rep_ == (int)((REP_MASK >> 2) & 1u)) ? 0 : 2); }
        if (cslot == 2) { REPEAT(16) { __syncthreads(); convert_experts(F, 0, 0, I_GU8L); } }
        SEAM(3); }
    if (IN(4)) {
        REPEAT(4) {
        const bool conv_first = (F.vcu & 1) == 0;
        if (conv_first && rep_ == 0) { convert_experts(F, 0, I_GU8L, I_GU8L + I_DN8L); }
        const int n = moe_build(F, 0, 8, true, F.in[21]);
        pg8::MoeSched S{(const LAS int*)(F.misc + M_TAB), n, (const char*)(F.ws + WS_H8), (const char*)(F.ws + WS_WGU), (size_t)0, (size_t)2048 * 1024, (size_t)256 * 1024};
        EpiGu E{F.ws + WS_ACT, (const LAS float*)(F.lds + BIAS_OFF)};
        pg8::gemm_phase<true, true, false>(F.lds, pg8::GemmP{1024, 1024, 8}, S, E, F.wave, PROBE_NOEPI && rep_ > 0);
        if (!conv_first && rep_ == 0) { __syncthreads(); convert_experts(F, 0, I_GU8L, I_GU8L + I_DN8L); }
        }
        SEAM(4);
    }
    if (IN(5)) {
        REPEAT(5) {
        const int n = moe_build(F, 0, 4, false, F.in[23]);
        pg8::MoeSched S{(const LAS int*)(F.misc + M_TAB), n, (const char*)(F.ws + WS_ACT), (const char*)(F.ws + WS_WDN), (size_t)256 * 1024, (size_t)1024 * 1024, (size_t)256 * 1024};
        EpiDown E{F.ws + WS_YS, (const LAS float*)(F.lds + BIAS_OFF), (const LAS int*)(F.lds + TOK_OFF)};
        pg8::gemm_phase<true, false, false>(F.lds, pg8::GemmP{1024, 1024, 8}, S, E, F.wave, PROBE_NOEPI && rep_ > 0);
        }
        SEAM(5);
    }
    if (IN(6)) { REPEAT(6) { combine_phase<0>(F, X1, X2, NT, 0); } SEAM(6); }
    if (IN(7)) {
        REPEAT(7) {
        pg8::PlainSched S{NT / 256, 3, (NT / 256) * 3, F.G, (int)blockIdx.x, (const char*)(F.ws + WS_H8), (const char*)(F.ws + WS_WP1), (size_t)256 * 1024, 0, (size_t)256 * 1024};
        EpiP1 E{F.ws + WS_QA, F.ws + WS_CKV, ssq};
        pg8::gemm_phase<true, false, false>(F.lds, pg8::GemmP{1024, 1024, 8}, S, E, F.wave, PROBE_NOEPI && rep_ > 0);
        }
        SEAM(7);
    }
    if (IN(8)) {
        REPEAT(8) {
        const int n = proj2_build(F);
        Proj2Sched S{(const LAS int*)(F.misc + M_TAB), n};
        EpiProj2 E{EpiKpe{F.ws + WS_K, rope}, EpiUq{F.ws + WS_Q, (const LAS float*)(F.lds + TOK_OFF), rope}, EpiUkv{F.ws + WS_K, (bf16_t*)(F.ws + WS_V), (const LAS float*)(F.lds + TOK_OFF)}};
        pg8::gemm_phase<true, false, true>(F.lds, pg8::GemmP{0, 0, 0}, S, E, F.wave, PROBE_NOEPI && rep_ > 0);
        }
        SEAM(8);
    }
    if (IN(9)) {
        REPEAT(9) {
        const unsigned char* Q = F.ws + WS_Q; const unsigned char* K = F.ws + WS_K; const bf16_t* V = (const bf16_t*)(F.ws + WS_V); unsigned char* O = F.ws + WS_ATT;
        const int cslot = (F.vcu + 1) % 3;
        int k = 0;
        for (int u = F.vcu; u < NB * NH * (SEQ / 256); u += F.G, ++k) { const int qb = u & 7, bh = u >> 3, b = bh >> 3, h = bh & 7;
            __syncthreads();
            if (k == cslot && rep_ == 0) { convert_experts(F, 1, 0, I_GU8L + I_DN8L); __syncthreads(); }
            att::attn_unit<0>(Q + ((size_t)bh * SEQ + qb * 256) * DQK, K + (size_t)bh * SKV * DQK, V + (size_t)bh * SKV * DV, O + ((size_t)b * SEQ + qb * 256) * 1024 + h * 128, F.lds, F.wave); }
        if (cslot == 2 && rep_ == 0) { __syncthreads(); convert_experts(F, 1, 0, I_GU8L + I_DN8L); }
        }
        SEAM(9);
    }
    if (IN(10)) {
        REPEAT(10) {
        pg8::PlainSched S{NL / 256, 4, (NL / 256) * 4, F.G, (int)blockIdx.x, (const char*)(F.ws + WS_ATT), (const char*)(F.ws + WS_WO), (size_t)256 * 1024, 0, (size_t)256 * 1024};
        EpiWo E{X2, X3, modv + 9 * 6144};
        pg8::gemm_phase<true, false, false>(F.lds, pg8::GemmP{1024, 1024, 8}, S, E, F.wave, PROBE_NOEPI && rep_ > 0);
        }
        SEAM(10);
    }
    if (PROBE_ATT != 0 && IN(11)) {
        const unsigned char* Q = F.ws + WS_Q; const unsigned char* K = F.ws + WS_K; const bf16_t* V = (const bf16_t*)(F.ws + WS_V); unsigned char* O = F.ws + WS_ATT;
        for (int u = F.vcu; u < NB * NH * (SEQ / 256); u += F.G) { const int qb = u & 7, bh = u >> 3, b = bh >> 3, h = bh & 7;
            __syncthreads();
            att::attn_unit<PROBE_ATT>(Q + ((size_t)bh * SEQ + qb * 256) * DQK, K + (size_t)bh * SKV * DQK, V + (size_t)bh * SKV * DV, O + ((size_t)b * SEQ + qb * 256) * 1024 + h * 128, F.lds, F.wave); }
        __syncthreads(); }
    if (IN(11)) { REPEAT(11) { route_phase(F, X3, NL, 1, (rep_ == (int)((REP_MASK >> 11) & 1u)) ? 1 : 3); } SEAM(11); }
    if (IN(12)) {
        REPEAT(12) {
        const int n = moe_build(F, 1, 8, true, F.in[21] + 32 * 2048);
        pg8::MoeSched S{(const LAS int*)(F.misc + M_TAB), n, (const char*)(F.ws + WS_H8), (const char*)(F.ws + WS_WGU) + (size_t)32 * 2048 * 1024, (size_t)0, (size_t)2048 * 1024, (size_t)256 * 1024};
        EpiGu E{F.ws + WS_ACT, (const LAS float*)(F.lds + BIAS_OFF)};
        pg8::gemm_phase<true, true, false>(F.lds, pg8::GemmP{1024, 1024, 8}, S, E, F.wave, PROBE_NOEPI && rep_ > 0);
        }
        SEAM(12);
    }
    if (IN(13)) {
        REPEAT(13) {
        const int n = moe_build(F, 1, 4, false, F.in[23] + 32 * 1024);
        pg8::MoeSched S{(const LAS int*)(F.misc + M_TAB), n, (const char*)(F.ws + WS_ACT), (const char*)(F.ws + WS_WDN) + (size_t)32 * 1024 * 1024, (size_t)256 * 1024, (size_t)1024 * 1024, (size_t)256 * 1024};
        EpiDown E{F.ws + WS_YS, (const LAS float*)(F.lds + BIAS_OFF), (const LAS int*)(F.lds + TOK_OFF)};
        pg8::gemm_phase<true, false, false>(F.lds, pg8::GemmP{1024, 1024, 8}, S, E, F.wave, PROBE_NOEPI && rep_ > 0);
        }
        SEAM(13);
    }
    if (IN(14)) { REPEAT(14) { combine_phase<1>(F, X3, F.out, NL, 1); } }
#undef IN
#undef SEAM
}

extern "C" void kernel_launch(void* const* d_in, const int* in_sizes, int n_in, void* d_out, int out_size, void* d_ws, size_t ws_size, hipStream_t stream) {
    static int ready = 0;
    if (ready == 0) {
        if (n_in != 25 || out_size != NL * D || ws_size < WS_END) { fprintf(stderr, "kernel_launch: unexpected shapes: n_in %d out %d ws %zu (need >= %zu)\n", n_in, out_size, ws_size, (size_t)WS_END); ready = -1; return; }
        if (hipFuncSetAttribute((const void*)trunk_fwd, hipFuncAttributeMaxDynamicSharedMemorySize, LDS_BYTES) != hipSuccess) { fprintf(stderr, "kernel_launch: hipFuncSetAttribute failed\n"); ready = -1; return; }
        int per_cu = 0;
        if (hipOccupancyMaxActiveBlocksPerMultiprocessor(&per_cu, (const void*)trunk_fwd, NTHR, LDS_BYTES) != hipSuccess || per_cu < 1)
            fprintf(stderr, "kernel_launch: note: occupancy query reports %d workgroups per CU\n", per_cu);
        (void)hipGetLastError();
        ready = 1;
    }
    if (ready < 0) return;
    (void)hipMemsetAsync((char*)d_ws + WS_CTL, 0, CTL_ZERO_BYTES, stream);
    Args a{};
    for (int i = 0; i < 25; ++i) a.in[i] = (const float*)d_in[i];
    a.out = (float*)d_out; a.ws = (unsigned char*)d_ws;
#if MK_PER_PHASE
    for (int p = 0; p < NPHASE; ++p) { a.ph_lo = p; a.ph_hi = p + 1; hipLaunchKernelGGL(trunk_fwd, dim3(GRID), dim3(NTHR), LDS_BYTES, stream, a); }
#else
    a.ph_lo = 0; a.ph_hi = NPHASE; hipLaunchKernelGGL(trunk_fwd, dim3(GRID), dim3(NTHR), LDS_BYTES, stream, a);
#endif
    const hipError_t le = hipPeekAtLastError();
    if (le != hipSuccess) fprintf(stderr, "kernel_launch: launch failed: %s\n", hipGetErrorName(le));
}
```

```cpp
#include <hip/hip_runtime.h>
#include <cstdio>
#include <cstdint>

#ifndef MK_PER_PHASE
#define MK_PER_PHASE 0
#endif

#ifndef REP_MASK
#define REP_MASK 0u
#endif
#ifndef PROBE_ATT
#define PROBE_ATT 0
#endif
#ifndef PROBE_NOEPI
#define PROBE_NOEPI 0
#endif
__device__ __forceinline__ int rep_bound(int v) { if (REP_MASK != 0u) asm volatile("" : "+s"(v)); return v; }
#define REPEAT(k) _Pragma("nounroll") for (int rep_ = 0, repn_ = rep_bound((int)((REP_MASK >> (k)) & 1u)); rep_ <= repn_; ++rep_) if (rep_ > 0 ? (__syncthreads(), true) : true)
#define LAS __attribute__((address_space(3)))
typedef unsigned short bf16_t;
typedef short bf16x8 __attribute__((ext_vector_type(8)));
typedef short s16x4 __attribute__((ext_vector_type(4)));
typedef float f32x4 __attribute__((ext_vector_type(4)));
typedef float f32x2 __attribute__((ext_vector_type(2)));
typedef float f32x16 __attribute__((ext_vector_type(16)));
typedef unsigned u32x4 __attribute__((ext_vector_type(4)));
typedef unsigned u32x2 __attribute__((ext_vector_type(2)));

constexpr int D = 1024, NB = 8, SEQ = 2048, CTXL = 256;
constexpr int NL = NB * SEQ, NC = NB * CTXL, NT = NL + NC;
constexpr int NE = 32, TOPK = 4;
constexpr int NH = 8, QLORA = 512, KVLORA = 256, DNOPE = 128, DROPE = 64, DV = 128, DQK = 192, SKV = CTXL + SEQ;
constexpr float EPS = 1e-6f;
constexpr int MAXSLOT0 = NT * TOPK + NE * 256;
constexpr int NWAVES = 8, NTHR = 512, GRID = 256;

constexpr size_t MiB = 1u << 20;
constexpr size_t WS_CTL = 0, CTL_ZERO_BYTES = 64 * 1024;
constexpr size_t WS_MODV = 1 * MiB;
constexpr size_t WS_ROPE = WS_MODV + 512 * 1024;
constexpr size_t WS_RWT = WS_ROPE + 64 * 1024;
constexpr size_t WS_SSQ = 2 * MiB;
constexpr size_t WS_ROUTE = 3 * MiB;
constexpr size_t WS_BLKCNT = WS_ROUTE + 3 * (size_t)NT * 4 * 4;
constexpr size_t WS_SLOTAID = 1326 * MiB;
constexpr size_t WS_SLOTTOK = 1330 * MiB;
constexpr size_t WS_WPOOL = 5 * MiB, WS_WP1 = 6 * MiB, WS_WUQ = 8 * MiB, WS_WUKV = 10 * MiB, WS_WO = 12 * MiB;
constexpr size_t WS_WGU = 16 * MiB;
constexpr size_t WS_WDN = 272 * MiB;
constexpr size_t WS_H8 = 1306 * MiB;
constexpr size_t WS_X1 = 400 * MiB, WS_X2 = 472 * MiB, WS_X3 = 544 * MiB;
constexpr size_t WS_H = 608 * MiB;
constexpr size_t WS_XS = 644 * MiB, WS_ACT = 804 * MiB, WS_YS = 964 * MiB;
constexpr size_t WS_QA = 1108 * MiB, WS_CKV = 1126 * MiB, WS_Q = 1136 * MiB, WS_K = 1184 * MiB, WS_V = 1238 * MiB, WS_ATT = 1274 * MiB;
constexpr size_t WS_END = 1334 * MiB;
constexpr int CW_BAR = 1024;
constexpr int CW_GCOUNT = 8192;

constexpr int RING_BYTES = 131072;
constexpr int MISC_OFF = 154624;
constexpr int LDS_BYTES = 163840;
constexpr int M_BAR = 0, M_TAB = 64, M_TSTART = 640, M_GCNT = 896, M_LCNT = 1024, M_LBASE = 1152, M_RINV = 8192;
constexpr int TOK_OFF = 131072;
constexpr int BIAS_OFF = TOK_OFF + 10240;

__device__ __forceinline__ unsigned f2bf(float f) { unsigned u = __builtin_bit_cast(unsigned, f); return (u + 0x7fffu + ((u >> 16) & 1u)) >> 16; }
__device__ __forceinline__ unsigned pk2(float lo, float hi) { return f2bf(lo) | (f2bf(hi) << 16); }
__device__ __forceinline__ unsigned cvt_pk_bf16(float lo, float hi) { unsigned r; asm volatile("v_cvt_pk_bf16_f32 %0, %1, %2" : "=v"(r) : "v"(lo), "v"(hi)); return r; }
__device__ __forceinline__ float bf_lo(unsigned w) { return __builtin_bit_cast(float, w << 16); }
__device__ __forceinline__ float bf_hi(unsigned w) { return __builtin_bit_cast(float, w & 0xffff0000u); }
__device__ __forceinline__ float wave_sum(float v) {
#pragma unroll
    for (int o = 1; o < 64; o <<= 1) v += __shfl_xor(v, o);
    return v;
}
__device__ __forceinline__ int opq(int v) { asm volatile("" : "+v"(v)); return v; }
__device__ __forceinline__ int lane_id() { int v; asm volatile("v_mbcnt_lo_u32_b32 %0, -1, 0\n\tv_mbcnt_hi_u32_b32 %0, -1, %0" : "=v"(v)); return v; }
__device__ __forceinline__ float clamp8(float v) { return fminf(fmaxf(v, -448.f), 448.f); }
__device__ __forceinline__ unsigned pk_fp8x4(f32x4 v) { int p = __builtin_amdgcn_cvt_pk_fp8_f32(clamp8(v.x), clamp8(v.y), 0, false); p = __builtin_amdgcn_cvt_pk_fp8_f32(clamp8(v.z), clamp8(v.w), p, true); return (unsigned)p; }
__device__ __forceinline__ const char* uni_ptr(const char* p) { const unsigned long long x = (unsigned long long)p; const unsigned lo = __builtin_amdgcn_readfirstlane((unsigned)x), hi = __builtin_amdgcn_readfirstlane((unsigned)(x >> 32)); return (const char*)(((unsigned long long)hi << 32) | lo); }
#ifndef WT_STORES
#define WT_STORES 0
#endif
__device__ __forceinline__ void gst16(void* p, u32x4 v) {
#if WT_STORES
    asm volatile("global_store_dwordx4 %0, %1, off sc1" :: "v"(p), "v"(v) : "memory");
#else
    *(u32x4*)p = v;
#endif
}
__device__ __forceinline__ void gst16(void* p, f32x4 v) { gst16(p, __builtin_bit_cast(u32x4, v)); }
__device__ __forceinline__ u32x2 pk_fp8x8(f32x4 a, f32x4 b, float sc) { u32x2 r; r.x = pk_fp8x4(a * sc); r.y = pk_fp8x4(b * sc); return r; }
__device__ __forceinline__ void unpk8(u32x4 w, f32x4& a, f32x4& b) { a = (f32x4){bf_lo(w.x), bf_hi(w.x), bf_lo(w.y), bf_hi(w.y)}; b = (f32x4){bf_lo(w.z), bf_hi(w.z), bf_lo(w.w), bf_hi(w.w)}; }
__device__ __forceinline__ u32x4 pk8(f32x4 a, f32x4 b) { u32x4 w; w.x = pk2(a.x, a.y); w.y = pk2(a.z, a.w); w.z = pk2(b.x, b.y); w.w = pk2(b.z, b.w); return w; }
#define LDS_WAIT() asm volatile("s_waitcnt lgkmcnt(0)" ::: "memory")
#define VM_WAIT() asm volatile("s_waitcnt vmcnt(0)" ::: "memory")

#define XB_TMO      128
#define XB_XCNT(j)  (256  + 64 * (j))
#define XB_XSUB(j)  (1280 + 64 * (j))
#define XB_XGEN(j)  (2304 + 64 * (j))
#define XB_TOP      3328
#define XB_TOPGEN   3392
#define XCD_BAR_WORDS 3456
#define XB_SPIN_CAP (1u << 18)
__device__ __forceinline__ unsigned xb_ld(unsigned* p)              { return __hip_atomic_load(p, __ATOMIC_RELAXED, __HIP_MEMORY_SCOPE_AGENT); }
__device__ __forceinline__ unsigned xb_add(unsigned* p, unsigned v) { return __hip_atomic_fetch_add(p, v, __ATOMIC_RELAXED, __HIP_MEMORY_SCOPE_AGENT); }
__device__ __forceinline__ unsigned xb_xcc_id() { return (unsigned)__builtin_amdgcn_s_getreg((3 << 11) | 20) & 0xFu; }
#define XB_SPIN(cond, bar) do { unsigned _sp = 0; while (cond) { __builtin_amdgcn_s_sleep(1); \
    if ((++_sp & 255u) == 0u) { if (xb_ld(&(bar)[XB_TMO])) break; if (_sp > XB_SPIN_CAP) { atomicAdd(&(bar)[XB_TMO], 1u); break; } } } } while (0)
struct XcdBarrier { unsigned* bar; unsigned x; volatile LAS unsigned* st; };
__device__ __forceinline__ XcdBarrier xcd_barrier_post(unsigned* bar, volatile LAS unsigned* st) {
    XcdBarrier b; b.bar = bar; b.x = xb_xcc_id(); b.st = st;
    if (threadIdx.x == 0) (void)xb_add(&bar[XB_XCNT(b.x)], 1u);
    return b;
}
__device__ __forceinline__ void xcd_barrier_complete(unsigned* bar, unsigned x, unsigned& nloc, unsigned& nx) {
    const unsigned G = gridDim.x * gridDim.y * gridDim.z;
    unsigned sum, cnt, mine, sp = 0u;
    for (;;) {
        sum = 0u; cnt = 0u; mine = 0u;
#pragma unroll
        for (unsigned j = 0; j < 16; ++j) { const unsigned c = xb_ld(&bar[XB_XCNT(j)]); sum += c; cnt += (c > 0u) ? 1u : 0u; mine = (j == x) ? c : mine; }
        if (sum == G) break;
        __builtin_amdgcn_s_sleep(1);
        if ((++sp & 255u) == 0u) { if (xb_ld(&bar[XB_TMO])) break; if (sp > XB_SPIN_CAP) { atomicAdd(&bar[XB_TMO], 1u); break; } }
    }
    nloc = mine > 0u ? mine : 1u; nx = cnt > 0u ? cnt : 1u;
}
__device__ __forceinline__ void xcd_barrier(const XcdBarrier& b, bool leader) {
    asm volatile("s_waitcnt vmcnt(0)" ::: "memory");
    __syncthreads();
    if (leader) {
        unsigned* bar = b.bar;
        __builtin_amdgcn_s_waitcnt(0);
        unsigned nloc = b.st[0], nx = b.st[1];
        if (nloc == 0u) { xcd_barrier_complete(bar, b.x, nloc, nx); b.st[0] = nloc; b.st[1] = nx; }
        const unsigned old = xb_add(&bar[XB_XSUB(b.x)], 1u);
        const unsigned gen = old / nloc;
        if (old + 1u == (gen + 1u) * nloc) {
            __builtin_amdgcn_fence(__ATOMIC_RELEASE, "agent");
            asm volatile("s_waitcnt vmcnt(0)" ::: "memory");
            const unsigned og = xb_add(&bar[XB_TOP], 1u);
            const unsigned tg = og / nx;
            if (og + 1u == (tg + 1u) * nx) xb_add(&bar[XB_TOPGEN], 1u);
            else XB_SPIN(xb_ld(&bar[XB_TOPGEN]) == tg, bar);
            __builtin_amdgcn_fence(__ATOMIC_ACQUIRE, "agent");
            xb_add(&bar[XB_XGEN(b.x)], 1u);
            asm volatile("s_waitcnt vmcnt(0)" ::: "memory");
        } else {
            XB_SPIN(xb_ld(&bar[XB_XGEN(b.x)]) == gen, bar);
            __builtin_amdgcn_fence(__ATOMIC_ACQUIRE, "agent");
            asm volatile("s_waitcnt vmcnt(0)" ::: "memory");
        }
    }
    __syncthreads();
}

namespace pg8 {
constexpr int BM = 256, BK = 64, HALF = 128, HTB = HALF * BK * 2, STAGE_BYTES = 8 * HTB;
__host__ __device__ __forceinline__ int lds_byte(int r, int c) { const int st = (r >> 4) * 2 + (c >> 5), rr = r & 15, cc = c & 31, ob = rr * 64 + cc * 2; return st * 1024 + (ob ^ (((ob >> 9) & 1) << 5)); }
__host__ __device__ __forceinline__ void stage_rc(int b, int& R, int& C) { const int st = b / 1024, sb = b % 1024, swz = sb ^ (((sb >> 9) & 1) << 5); R = (st >> 1) * 16 + swz / 64; C = (st & 1) * 32 + (swz % 64) / 2; }
__host__ __device__ __forceinline__ int perm32(int rho) { const int n = rho >> 4, i = rho & 15; return 8 * (i >> 2) + 4 * n + (i & 3); }

struct Unit { int pm, pn, e, mt, nv, nt; const char* A; const char* B; };
struct GemmP { int ldaB, ldbB, nt; };
typedef int i32x4 __attribute__((ext_vector_type(4)));
typedef int i32x8 __attribute__((ext_vector_type(8)));
typedef float f32x8 __attribute__((ext_vector_type(8)));
__device__ __forceinline__ i32x8 cat8(bf16x8 a, bf16x8 b) { return __builtin_shufflevector(__builtin_bit_cast(i32x4, a), __builtin_bit_cast(i32x4, b), 0, 1, 2, 3, 4, 5, 6, 7); }

__device__ __forceinline__ int xcd_remap(int L, int nwg) { const int q = nwg / 8, r = nwg % 8, xcd = L % 8, off = L / 8; return (xcd < r ? xcd * (q + 1) : r * (q + 1) + (xcd - r) * q) + off; }

struct PlainSched {
    int nM, nN, nwg, G, c; const char* Ab; const char* Bb; size_t a_t, a_n, b_t;
    __device__ __forceinline__ bool next(int i, Unit& u) const {
        const int L = i * G + c; if (L >= nwg) return false;
        const int wgid = xcd_remap(L, nwg);
        const int nig = 8 * nN, gid = wgid / nig, fm = gid * 8, gsz = (nM - fm) < 8 ? (nM - fm) : 8;
        u.pm = fm + ((wgid % nig) % gsz); u.pn = (wgid % nig) / gsz; u.e = 0; u.mt = 0; u.nv = 256; u.nt = 0;
        u.A = Ab + (size_t)u.pm * a_t + (size_t)u.pn * a_n; u.B = Bb + (size_t)u.pn * b_t; return true;
    }
};
struct MoeSched {
    const LAS int* tab; int n; const char* Ab; const char* Bb; size_t a_t, b_e, b_t;
    __device__ __forceinline__ bool next(int i, Unit& u) const {
        if (i >= n) return false;
        u.pm = __builtin_amdgcn_readfirstlane(tab[8 * i]); u.pn = __builtin_amdgcn_readfirstlane(tab[8 * i + 1]); u.e = __builtin_amdgcn_readfirstlane(tab[8 * i + 2]);
        u.mt = __builtin_amdgcn_readfirstlane(tab[8 * i + 3]); u.nv = __builtin_amdgcn_readfirstlane(tab[8 * i + 4]); u.nt = i;
        u.A = Ab + (size_t)u.pm * a_t; u.B = Bb + (size_t)u.e * b_e + (size_t)u.pn * b_t; return true;
    }
};

template <bool FP8, bool GATHER, bool VARK, class Epi, class Sched>
__device__ __forceinline__ void gemm_phase(LAS unsigned char* lds, const GemmP g, const Sched& S, const Epi& E, int wave_s, bool skip_epi = false) {
    const int lane = opq(lane_id()), wid = wave_s, tid = wid * 64 + lane, wr = wid >> 2, wc = wid & 3, fr = lane & 15, fq = lane >> 4;
    int RA, RB, C2; { int R, C; stage_rc(tid * 16, R, C); RA = R; RB = Epi::PERM ? ((R & ~31) + perm32(R & 31)) : R; C2 = C * 2; }
    const LAS int* tokl = (const LAS int*)(lds + TOK_OFF); unsigned gof[2][2] = {{0u, 0u}, {0u, 0u}};
#define PG8_TOKOFF(ui_, h_, q_) ((unsigned)tokl[(ui_) * 256 + (h_) * 128 + (q_) * 64 + RA] * (unsigned)g.ldaB + (unsigned)C2)
    const size_t kstep = (size_t)(BK * 2);
    const unsigned ldsw = (unsigned)wid * 1024u;
    const int aoff = lds_byte(wr * 64 + fr, fq * 8), boff = lds_byte(wc * 32 + fr, fq * 8);
#define PG8_SA(b, h) (((b) * 2 + (h)) * HTB)
#define PG8_SB(b, h) ((4 + (b) * 2 + (h)) * HTB)
#define PG8_STAGE_X(bufoff, gbase, Rrow_, ld_) do { const unsigned vo_ = (unsigned)(Rrow_) * (unsigned)(ld_) + (unsigned)C2; _Pragma("unroll") for (int _i = 0; _i < 2; ++_i) { \
        const char* gb_ = uni_ptr((const char*)(gbase) + (size_t)_i * 64 * (ld_)); asm volatile("" : "+s"(gb_)); \
        __builtin_amdgcn_global_load_lds((const unsigned*)(gb_ + vo_), (LAS unsigned*)(lds + (bufoff) + ldsw + _i * 8192), 16, 0, 0); } } while (0)
#define PG8_STAGE_B(bufoff, bbase, h_, ld_) PG8_STAGE_X(bufoff, (bbase) + (size_t)(h_) * 128 * (ld_), RB, ld_)
#define PG8_STAGE_A(bufoff, abase, h_, ld_) do { if constexpr (GATHER) { _Pragma("unroll") for (int _i = 0; _i < 2; ++_i) { const char* gb_ = (const char*)(abase); asm volatile("" : "+s"(gb_)); \
        __builtin_amdgcn_global_load_lds((const unsigned*)(gb_ + gof[h_][_i]), (LAS unsigned*)(lds + (bufoff) + ldsw + _i * 8192), 16, 0, 0); } } \
        else { PG8_STAGE_X(bufoff, (abase) + (size_t)(h_) * 128 * (ld_), RA, ld_); } } while (0)
#define PG8_LDA(dst, b, h) do { _Pragma("unroll") for (int m = 0; m < 4; ++m) _Pragma("unroll") for (int k = 0; k < 2; ++k) dst[m][k] = *(const LAS bf16x8*)(lds + PG8_SA(b, h) + aoff + m * 2048 + k * 1024); } while (0)
#define PG8_LDB(dst, b, h) do { _Pragma("unroll") for (int n = 0; n < 2; ++n) _Pragma("unroll") for (int k = 0; k < 2; ++k) dst[n][k] = *(const LAS bf16x8*)(lds + PG8_SB(b, h) + boff + n * 2048 + k * 1024); } while (0)
#define PG8_MMA1(ai, bj, m, At, Bt, n, HALF_) do { f32x4 c_ = acc[ai][bj][m].HALF_; \
        if constexpr (FP8) c_ = __builtin_amdgcn_mfma_scale_f32_16x16x128_f8f6f4(cat8(Bt[n][0], Bt[n][1]), cat8(At[m][0], At[m][1]), c_, 0, 0, 0, 0, 0, 0); \
        else { _Pragma("unroll") for (int k = 0; k < 2; ++k) c_ = __builtin_amdgcn_mfma_f32_16x16x32_bf16(Bt[n][k], At[m][k], c_, 0, 0, 0); } \
        acc[ai][bj][m].HALF_ = c_; } while (0)
#define PG8_MMA(ai, bj, At, Bt) do { __builtin_amdgcn_s_setprio(1); _Pragma("unroll") for (int m = 0; m < 4; ++m) { PG8_MMA1(ai, bj, m, At, Bt, 0, lo); PG8_MMA1(ai, bj, m, At, Bt, 1, hi); } \
        __builtin_amdgcn_s_setprio(0); } while (0)
#define PG8_WAIT_V(n) asm volatile("s_waitcnt vmcnt(" #n ")" ::: "memory")
#define PG8_WAIT_L(n) asm volatile("s_waitcnt lgkmcnt(" #n ")" ::: "memory")
#define PG8_BAR __builtin_amdgcn_s_barrier()
#define PG8_SCHED __builtin_amdgcn_sched_barrier(0)
    Unit cur, nxt; int ui = 0;
    if (!S.next(0, cur)) return;
    const char* cA = cur.A; const char* cB = cur.B;
    int ntc = VARK ? cur.nt : g.nt; unsigned ldAc = VARK ? 128u * (unsigned)cur.nt : (unsigned)g.ldaB, ldBc = VARK ? 128u * (unsigned)cur.nt : (unsigned)g.ldbB;
    if constexpr (GATHER) {
#pragma unroll
        for (int h = 0; h < 2; ++h)
#pragma unroll
            for (int q = 0; q < 2; ++q) gof[h][q] = PG8_TOKOFF(0, h, q); }
    PG8_STAGE_B(PG8_SB(0, 0), cB, 0, ldBc); PG8_STAGE_B(PG8_SB(0, 1), cB, 1, ldBc); PG8_STAGE_A(PG8_SA(0, 0), cA, 0, ldAc); PG8_STAGE_A(PG8_SA(0, 1), cA, 1, ldAc);
    if (wr == 1) PG8_BAR;
    PG8_WAIT_V(2); PG8_BAR;
    PG8_STAGE_B(PG8_SB(1, 0), cB + kstep, 0, ldBc); PG8_STAGE_A(PG8_SA(1, 0), cA + kstep, 0, ldAc); PG8_STAGE_B(PG8_SB(1, 1), cB + kstep, 1, ldBc);
    PG8_WAIT_V(6); PG8_BAR;
    f32x8 acc[2][2][4];
#pragma unroll
    for (int a = 0; a < 2; ++a)
#pragma unroll
        for (int b = 0; b < 2; ++b)
#pragma unroll
            for (int m = 0; m < 4; ++m) acc[a][b][m] = (f32x8){0.f, 0.f, 0.f, 0.f, 0.f, 0.f, 0.f, 0.f};
    bf16x8 At[4][2], B0[2][2], B1[2][2];
    for (;;) {
        const bool has_next = S.next(ui + 1, nxt);
        const char* nA = has_next ? nxt.A : cA; const char* nB = has_next ? nxt.B : cB;
        const int ntn = (VARK && has_next) ? nxt.nt : ntc; const unsigned ldAn = (VARK && has_next) ? 128u * (unsigned)nxt.nt : ldAc, ldBn = (VARK && has_next) ? 128u * (unsigned)nxt.nt : ldBc;
#pragma nounroll
        for (int t = 0; t < ntc; t += 2) {
            const bool last = (t == ntc - 2);
            const char* a1 = cA + (size_t)(t + 1) * kstep;
            const char* a2 = last ? nA : cA + (size_t)(t + 2) * kstep; const char* b2 = last ? nB : cB + (size_t)(t + 2) * kstep;
            const char* a3 = a2 + kstep; const char* b3 = b2 + kstep;
            const unsigned ldAx = last ? ldAn : ldAc, ldBx = last ? ldBn : ldBc;
            if constexpr (GATHER) { if (last && has_next) { gof[0][0] = PG8_TOKOFF(ui + 1, 0, 0); gof[0][1] = PG8_TOKOFF(ui + 1, 0, 1); } }
            PG8_LDB(B0, 0, 0); PG8_LDB(B1, 0, 1); PG8_SCHED; PG8_LDA(At, 0, 0); PG8_STAGE_A(PG8_SA(1, 1), a1, 1, ldAc);
            if constexpr (GATHER) { if (last && has_next) { gof[1][0] = PG8_TOKOFF(ui + 1, 1, 0); gof[1][1] = PG8_TOKOFF(ui + 1, 1, 1); } }
            PG8_WAIT_V(8); PG8_WAIT_L(0); PG8_BAR; PG8_MMA(0, 0, At, B0); PG8_MMA(0, 1, At, B1); PG8_BAR; PG8_SCHED;
            PG8_LDA(At, 0, 1); PG8_STAGE_B(PG8_SB(0, 0), b2, 0, ldBx); PG8_STAGE_B(PG8_SB(0, 1), b2, 1, ldBx); PG8_STAGE_A(PG8_SA(0, 0), a2, 0, ldAx);
            PG8_WAIT_V(8); PG8_WAIT_L(0); PG8_BAR; PG8_MMA(1, 0, At, B0); PG8_MMA(1, 1, At, B1); PG8_BAR; PG8_SCHED;
            PG8_LDB(B0, 1, 0); PG8_LDB(B1, 1, 1); PG8_SCHED; PG8_LDA(At, 1, 0); PG8_STAGE_A(PG8_SA(0, 1), a2, 1, ldAx);
            PG8_WAIT_V(8); PG8_WAIT_L(0); PG8_BAR; PG8_MMA(0, 0, At, B0); PG8_MMA(0, 1, At, B1); PG8_BAR; PG8_SCHED;
            PG8_LDA(At, 1, 1); PG8_STAGE_B(PG8_SB(1, 0), b3, 0, ldBx); PG8_STAGE_B(PG8_SB(1, 1), b3, 1, ldBx); PG8_STAGE_A(PG8_SA(1, 0), a3, 0, ldAx);
            PG8_WAIT_V(8); PG8_WAIT_L(0); PG8_BAR; PG8_MMA(1, 0, At, B0); PG8_MMA(1, 1, At, B1); PG8_BAR; PG8_SCHED;
        }
        if (wr == 0) PG8_BAR;
        { const int lane2 = opq(lane_id()); f32x4 accv[2][2][4][2];
#pragma unroll
          for (int a = 0; a < 2; ++a)
#pragma unroll
              for (int b = 0; b < 2; ++b)
#pragma unroll
                  for (int m = 0; m < 4; ++m) { accv[a][b][m][0] = acc[a][b][m].lo; accv[a][b][m][1] = acc[a][b][m].hi; }
          if (!skip_epi) E(accv, cur, wr, wc, lane2 & 15, lane2 >> 4); }
        if (!has_next) break;
#pragma unroll
        for (int a = 0; a < 2; ++a)
#pragma unroll
            for (int b = 0; b < 2; ++b)
#pragma unroll
                for (int m = 0; m < 4; ++m) acc[a][b][m] = (f32x8){0.f, 0.f, 0.f, 0.f, 0.f, 0.f, 0.f, 0.f};
        cur = nxt; cA = nA; cB = nB; ntc = ntn; ldAc = ldAn; ldBc = ldBn; ++ui;
        if (wr == 1) PG8_BAR;
    }
    PG8_WAIT_V(0);
    PG8_BAR;
#undef PG8_SA
#undef PG8_SB
#undef PG8_STAGE_X
#undef PG8_STAGE_B
#undef PG8_STAGE_A
#undef PG8_TOKOFF
#undef PG8_LDA
#undef PG8_LDB
#undef PG8_MMA
#undef PG8_MMA1
#undef PG8_WAIT_V
#undef PG8_WAIT_L
#undef PG8_BAR
#undef PG8_SCHED
}
}
using pg8::Unit;

typedef f32x4 AccT[2][2][4][2];

struct EpiPool {
    static constexpr bool PERM = true;
    const float* x; const float* ctx; bf16_t* x1; const float* pb; const float* ps; const float* modv0;
    __device__ __forceinline__ void operator()(const AccT& acc, const Unit& u, int wr, int wc, int fr, int fq) const {
        const int bidx = u.pm < 64 ? (u.pm >> 3) : 8;
        const float* g1 = modv0 + (bidx * 6 + 2) * 1024;
        const float* src = u.pm < 64 ? x + (size_t)u.pm * 256 * 1024 : ctx + (size_t)(u.pm - 64) * 256 * 1024;
        bf16_t* dst = x1 + (size_t)u.pm * 256 * 1024;
        const int col0 = u.pn * 256 + wc * 32 + 8 * fq;
        f32x4 mul[2][2], add[2][2];
#pragma unroll
        for (int bj = 0; bj < 2; ++bj)
#pragma unroll
            for (int n = 0; n < 2; ++n) { const int c = col0 + bj * 128 + n * 4; const f32x4 bv = *(const f32x4*)(pb + c), sv = *(const f32x4*)(ps + c), gv = *(const f32x4*)(g1 + c);
                mul[bj][n] = sv * gv; add[bj][n] = bv * mul[bj][n]; }
#pragma unroll
        for (int ai = 0; ai < 2; ++ai)
#pragma unroll
            for (int m = 0; m < 4; ++m) { const size_t ro = (size_t)(ai * 128 + wr * 64 + m * 16 + fr) * 1024 + col0;
#pragma unroll
                for (int bj = 0; bj < 2; ++bj) { const f32x4 x0 = *(const f32x4*)(src + ro + bj * 128), x1v = *(const f32x4*)(src + ro + bj * 128 + 4);
                    *(u32x4*)(dst + ro + bj * 128) = pk8(x0 + acc[ai][bj][m][0] * mul[bj][0] + add[bj][0], x1v + acc[ai][bj][m][1] * mul[bj][1] + add[bj][1]); } }
    }
};

__device__ __forceinline__ f32x2 swiglu4_pk(f32x2 g, f32x2 u) {
    g.x = fminf(g.x, 7.0f); g.y = fminf(g.y, 7.0f);
    u.x = __builtin_amdgcn_fmed3f(u.x, -7.0f, 7.0f); u.y = __builtin_amdgcn_fmed3f(u.y, -7.0f, 7.0f);
    f32x2 t = g * (-1.702f * 1.4426950408889634f);
    t.x = __builtin_amdgcn_exp2f(t.x); t.y = __builtin_amdgcn_exp2f(t.y);
    t = t + 1.0f;
    t.x = __builtin_amdgcn_rcpf(t.x); t.y = __builtin_amdgcn_rcpf(t.y);
    return (u * 4.0f + 4.0f) * (g * t);
}
struct EpiGu {
    static constexpr bool PERM = true;
    unsigned char* act; const LAS float* biasl;
    __device__ __forceinline__ void operator()(const AccT& acc, const Unit& u, int wr, int wc, int fr, int fq) const {
        const LAS float* bias = biasl + u.nt * 256 + wc * 32 + 8 * fq; const int gcol0 = u.pn * 128 + wc * 32 + 8 * fq;
        f32x4 bg[2], bu[2];
#pragma unroll
        for (int n = 0; n < 2; ++n) { bg[n] = *(const LAS f32x4*)(bias + 4 * n); bu[n] = *(const LAS f32x4*)(bias + 128 + 4 * n); }
        unsigned char* ap = act + (size_t)u.pm * 256 * 1024 + (size_t)(wr * 64 + (fq & 1) * 16 + fr) * 1024 + u.pn * 128 + wc * 32 + 16 * (fq >> 1);
#pragma unroll
        for (int ai = 0; ai < 2; ++ai)
#pragma unroll
            for (int mp = 0; mp < 2; ++mp) {
                u32x2 w[2];
#pragma unroll
                for (int mo = 0; mo < 2; ++mo) { const int m = 2 * mp + mo;
#pragma unroll
                    for (int n = 0; n < 2; ++n) { const f32x4 gv = acc[ai][0][m][n] * (1.0f / 512.0f) + bg[n], uv = acc[ai][1][m][n] * (1.0f / 512.0f) + bu[n];
                        const f32x2 a0 = swiglu4_pk((f32x2){gv.x, gv.y}, (f32x2){uv.x, uv.y}), a1 = swiglu4_pk((f32x2){gv.z, gv.w}, (f32x2){uv.z, uv.w});
                        int p = __builtin_amdgcn_cvt_pk_fp8_f32(a0.x, a0.y, 0, false); p = __builtin_amdgcn_cvt_pk_fp8_f32(a1.x, a1.y, p, true); w[mo][n] = (unsigned)p; } }
                const auto r0 = __builtin_amdgcn_permlane16_swap(w[0].x, w[1].x, false, false), r1 = __builtin_amdgcn_permlane16_swap(w[0].y, w[1].y, false, false);
                const u32x4 o = {r0[0], r1[0], r0[1], r1[1]};
                *(u32x4*)(ap + (size_t)(ai * 128 + mp * 32) * 1024) = o; __builtin_amdgcn_sched_barrier(0); }
    }
};
struct EpiDown {
    static constexpr bool PERM = true;
    unsigned char* ys; const LAS float* biasl; const LAS int* aidl;
    __device__ __forceinline__ void operator()(const AccT& acc, const Unit& u, int wr, int wc, int fr, int fq) const {
        const LAS float* bias = biasl + u.nt * 256 + wc * 64 + 16 * fq; const int col0 = u.pn * 256 + wc * 64 + 16 * fq;
        f32x4 bv[4];
#pragma unroll
        for (int q = 0; q < 4; ++q) bv[q] = *(const LAS f32x4*)(bias + 4 * q) * 16.0f;
#pragma unroll
        for (int ai = 0; ai < 2; ++ai)
#pragma unroll
            for (int m = 0; m < 4; ++m) { const int r = ai * 128 + wr * 64 + m * 16 + fr; const int aid = aidl[u.nt * 256 + r]; const bool valid = aid >= 0;
                if (valid) { u32x4 w;
#pragma unroll
                    for (int bj = 0; bj < 2; ++bj)
#pragma unroll
                        for (int n = 0; n < 2; ++n) w[2 * bj + n] = pk_fp8x4(acc[ai][bj][m][n] * (1.0f / 16.0f) + bv[2 * bj + n]);
                    *(u32x4*)(ys + (size_t)aid * 1024 + col0) = w; } __builtin_amdgcn_sched_barrier(0); }
    }
};
__device__ __forceinline__ void row_bk(int row, int& b, int& key) { if (row < NL) { b = row >> 11; key = CTXL + (row & 2047); } else { const int r = row - NL; b = r >> 8; key = r & 255; } }
__device__ __forceinline__ void rope_rot(f32x4 x1, f32x4 x2, const f32x2* rope, int pos, int fq, bool rot, f32x4& o1, f32x4& o2) {
    o1 = x1; o2 = x2;
    if (rot) {
#pragma unroll
        for (int j = 0; j < 4; ++j) { const f32x2 cs = rope[pos * 16 + 4 * fq + j]; o1[j] = x1[j] * cs.x - x2[j] * cs.y; o2[j] = x2[j] * cs.x + x1[j] * cs.y; } }
}
struct EpiP1 {
    static constexpr bool PERM = true;
    unsigned char* qa; unsigned char* ckv; float* ssq;
    __device__ __forceinline__ void operator()(const AccT& acc, const Unit& u, int wr, int wc, int fr, int fq) const {
        const int row0 = u.pm * 256 + wr * 64 + fr;
        unsigned char* dst = u.pn < 2 ? qa : ckv; const int ld = u.pn < 2 ? 512 : 256, colt = (u.pn < 2 ? u.pn * 256 : 0) + wc * 32 + 8 * fq;
#pragma unroll
        for (int ai = 0; ai < 2; ++ai)
#pragma unroll
            for (int m = 0; m < 4; ++m) { const int row = row0 + ai * 128 + m * 16; float ss = 0.f;
#pragma unroll
                for (int bj = 0; bj < 2; ++bj) { const f32x4 v0 = acc[ai][bj][m][0] * (1.0f / 512.0f), v1 = acc[ai][bj][m][1] * (1.0f / 512.0f);
                    ss += (v0[0] * v0[0] + v0[1] * v0[1]) + (v0[2] * v0[2] + v0[3] * v0[3]) + (v1[0] * v1[0] + v1[1] * v1[1]) + (v1[2] * v1[2] + v1[3] * v1[3]);
                    *(u32x2*)(dst + (size_t)row * ld + colt + bj * 128) = pk_fp8x8(v0, v1, 8.0f); }
                ss += __shfl_xor(ss, 16); ss += __shfl_xor(ss, 32);
                if (fq == 0) ssq[(size_t)(u.pn * 4 + wc) * NT + row] = ss; }
    }
};
struct EpiKpe {
    static constexpr bool PERM = true;
    unsigned char* Kb; const f32x2* rope;
    __device__ __forceinline__ void operator()(const AccT& acc, const Unit& u, int wr, int wc, int fr, int fq) const {
        if (wc >= 2) return;
        const int row0 = u.pm * 256 + wr * 64 + fr;
#pragma unroll
        for (int ai = 0; ai < 2; ++ai)
#pragma unroll
            for (int m = 0; m < 4; ++m) { const int row = row0 + ai * 128 + m * 16; int b, key; row_bk(row, b, key);
                const int l = row & 2047, pos = wc == 0 ? (l >> 6) : (l & 63);
                f32x4 o1, o2; rope_rot(acc[ai][0][m][0] * (1.0f / 512.0f), acc[ai][0][m][1] * (1.0f / 512.0f), rope, pos, fq, row < NL, o1, o2);
                const u32x2 w = pk_fp8x8(o1, o2, 4.0f);
                unsigned char* kd = Kb + ((size_t)(b * NH) * SKV + key) * DQK + DNOPE + wc * 32 + 8 * fq;
#pragma unroll
                for (int h = 0; h < NH; ++h) *(u32x2*)(kd + (size_t)h * SKV * DQK) = w; }
    }
};
struct EpiUq {
    static constexpr bool PERM = true;
    unsigned char* Q; const LAS float* rinvl; const f32x2* rope;
    __device__ __forceinline__ void operator()(const AccT& acc, const Unit& u, int wr, int wc, int fr, int fq) const {
#pragma unroll
        for (int ai = 0; ai < 2; ++ai)
#pragma unroll
            for (int m = 0; m < 4; ++m) { const int rl = ai * 128 + wr * 64 + m * 16 + fr, row = u.pm * 256 + rl;
                const float rinv = rinvl[u.mt * 256 + rl];
                const int b = row >> 11, l = row & 2047;
#pragma unroll
                for (int bj = 0; bj < 2; ++bj) { const int cb = 8 * u.pn + 4 * bj + wc, head = cb / 6, wb = cb % 6;
                    unsigned char* dr = Q + ((size_t)(b * NH + head) * SEQ + l) * DQK;
                    const f32x4 v0 = acc[ai][bj][m][0] * rinv, v1 = acc[ai][bj][m][1] * rinv;
                    if (wb < 4) *(u32x2*)(dr + wb * 32 + 8 * fq) = pk_fp8x8(v0, v1, 4.0f);
                    else { const int axis = wb - 4, pos = axis == 0 ? (l >> 6) : (l & 63); f32x4 o1, o2; rope_rot(v0, v1, rope, pos, fq, true, o1, o2);
                        *(u32x2*)(dr + DNOPE + axis * 32 + 8 * fq) = pk_fp8x8(o1, o2, 4.0f); } } }
    }
};
struct EpiUkv {
    static constexpr bool PERM = true;
    unsigned char* Kb; bf16_t* Vb; const LAS float* rinvl;
    __device__ __forceinline__ void operator()(const AccT& acc, const Unit& u, int wr, int wc, int fr, int fq) const {
#pragma unroll
        for (int ai = 0; ai < 2; ++ai)
#pragma unroll
            for (int m = 0; m < 4; ++m) { const int rl = ai * 128 + wr * 64 + m * 16 + fr, row = u.pm * 256 + rl;
                const float rinv = rinvl[u.mt * 256 + rl];
                int b, key; row_bk(row, b, key);
                const size_t kr = (size_t)(b * NH + u.pn) * SKV + key;
                { const f32x4 v0 = acc[ai][0][m][0] * rinv, v1 = acc[ai][0][m][1] * rinv; *(u32x2*)(Kb + kr * DQK + wc * 32 + 8 * fq) = pk_fp8x8(v0, v1, 4.0f); }
                { const f32x4 v0 = acc[ai][1][m][0] * rinv, v1 = acc[ai][1][m][1] * rinv;
                  u32x4 w; w.x = cvt_pk_bf16(v0[0], v0[1]); w.y = cvt_pk_bf16(v0[2], v0[3]); w.z = cvt_pk_bf16(v1[0], v1[1]); w.w = cvt_pk_bf16(v1[2], v1[3]);
                  gst16(Vb + kr * DV + wc * 32 + 8 * fq, w); } }
    }
};
struct EpiWo {
    static constexpr bool PERM = true;
    const bf16_t* x2; bf16_t* x3; const float* modv1;
    __device__ __forceinline__ void operator()(const AccT& acc, const Unit& u, int wr, int wc, int fr, int fq) const {
        const float* g1 = modv1 + ((u.pm >> 3) * 6 + 2) * 1024; const int col0 = u.pn * 256 + wc * 32 + 8 * fq;
        f32x4 gv[2][2];
#pragma unroll
        for (int bj = 0; bj < 2; ++bj)
#pragma unroll
            for (int n = 0; n < 2; ++n) gv[bj][n] = *(const f32x4*)(g1 + col0 + bj * 128 + n * 4) * (1.0f / 4096.0f);
#pragma unroll
        for (int ai = 0; ai < 2; ++ai)
#pragma unroll
            for (int m = 0; m < 4; ++m) { const size_t ro = (size_t)(u.pm * 256 + ai * 128 + wr * 64 + m * 16 + fr) * 1024 + col0;
#pragma unroll
                for (int bj = 0; bj < 2; ++bj) { f32x4 xa, xb; unpk8(*(const u32x4*)(x2 + ro + bj * 128), xa, xb);
                    *(u32x4*)(x3 + ro + bj * 128) = pk8(xa + acc[ai][bj][m][0] * gv[bj][0], xb + acc[ai][bj][m][1] * gv[bj][1]); } }
    }
};
struct EpiProj2 {
    static constexpr bool PERM = true;
    EpiKpe k; EpiUq q; EpiUkv v;
    __device__ __forceinline__ void operator()(const AccT& acc, const Unit& u, int wr, int wc, int fr, int fq) const {
        if (u.e == 0) k(acc, u, wr, wc, fr, fq); else if (u.e == 1) q(acc, u, wr, wc, fr, fq); else v(acc, u, wr, wc, fr, fq);
    }
};
struct KpeSched {
    int c; const char* A; const char* B;
    __device__ __forceinline__ bool next(int i, Unit& u) const {
        if (i > 0 || c >= NT / 256) return false;
        u.pm = c; u.pn = 3; u.e = 0; u.mt = 0; u.nv = 256; u.nt = 0; u.A = A + (size_t)c * 256 * 1024; u.B = B; return true;
    }
};
struct Proj2Sched {
    const LAS int* tab; int n;
    __device__ __forceinline__ bool next(int i, Unit& u) const {
        if (i >= n) return false;
        u.pm = __builtin_amdgcn_readfirstlane(tab[8 * i]); u.pn = __builtin_amdgcn_readfirstlane(tab[8 * i + 1]); u.e = __builtin_amdgcn_readfirstlane(tab[8 * i + 2]); u.nt = __builtin_amdgcn_readfirstlane(tab[8 * i + 3]);
        u.mt = i; u.nv = 256;
        const unsigned alo = __builtin_amdgcn_readfirstlane(tab[8 * i + 4]), ahi = __builtin_amdgcn_readfirstlane(tab[8 * i + 5]), blo = __builtin_amdgcn_readfirstlane(tab[8 * i + 6]), bhi = __builtin_amdgcn_readfirstlane(tab[8 * i + 7]);
        u.A = (const char*)(((unsigned long long)ahi << 32) | alo); u.B = (const char*)(((unsigned long long)bhi << 32) | blo); return true;
    }
};

namespace att {
constexpr int QBLK = 32, KVBLK = 64, KROW = 208;
constexpr float SCALE = 0.07216878364870322f / 16.0f;
constexpr float THR = 8.f;
constexpr int NST = 3, SHM_V = KVBLK * DV * 2, SHM_K = KVBLK * KROW, LDS_NEED = NST * SHM_V + NST * SHM_K + NWAVES * 64 * 4;
#define SBAR() __builtin_amdgcn_sched_barrier(0)
__device__ __forceinline__ int crow(int r, int hi) { return (r & 3) + 8 * (r >> 2) + 4 * hi; }
__device__ __forceinline__ void partialSM(f32x16& p0, f32x16& p1, float& m_reg, float& mn, float& alpha) {
    constexpr float C = SCALE * 1.4426950408889634f;
    float pmax = p0[0];
#pragma unroll
    for (int r = 1; r < 16; ++r) pmax = fmaxf(pmax, p0[r]);
#pragma unroll
    for (int r = 0; r < 16; ++r) pmax = fmaxf(pmax, p1[r]);
    { auto rr = __builtin_amdgcn_permlane32_swap(__float_as_uint(pmax), __float_as_uint(pmax), false, false);
      pmax = fmaxf(__uint_as_float(rr[0]), __uint_as_float(rr[1])); }
    if (__builtin_expect(__all(pmax - m_reg <= THR / SCALE), 1)) { mn = m_reg; alpha = 1.f; }
    else { mn = fmaxf(m_reg, pmax); alpha = __builtin_amdgcn_exp2f((m_reg - mn) * C); m_reg = mn; }
    const float mnC = -mn * C;
#pragma unroll
    for (int r = 0; r < 16; ++r) p0[r] = fmaf(p0[r], C, mnC);
#pragma unroll
    for (int r = 0; r < 16; ++r) p1[r] = fmaf(p1[r], C, mnC);
#pragma unroll
    for (int r = 0; r < 16; ++r) p0[r] = __builtin_amdgcn_exp2f(p0[r]);
}
template <int VAR = 0> __device__ __forceinline__ void finishSM(f32x16& p0, f32x16& p1, float alpha, float& l_reg, bf16x8& pa0, bf16x8& pa1, bf16x8& pa2, bf16x8& pa3) {
    if constexpr (!(VAR & 1)) {
#pragma unroll
    for (int r = 0; r < 16; ++r) p1[r] = __builtin_amdgcn_exp2f(p1[r]); }
    float ps = 0;
#pragma unroll
    for (int r = 0; r < 16; ++r) ps += p0[r];
#pragma unroll
    for (int r = 0; r < 16; ++r) ps += p1[r];
    { auto rr = __builtin_amdgcn_permlane32_swap(__float_as_uint(ps), __float_as_uint(ps), false, false);
      ps = __uint_as_float(rr[0]) + __uint_as_float(rr[1]); }
    l_reg = l_reg * alpha + ps;
#define PK4(P, BASE, OUT) do { unsigned a0 = cvt_pk_bf16(P[BASE + 0], P[BASE + 1]), a1 = cvt_pk_bf16(P[BASE + 2], P[BASE + 3]);   \
    unsigned b0 = cvt_pk_bf16(P[BASE + 4], P[BASE + 5]), b1 = cvt_pk_bf16(P[BASE + 6], P[BASE + 7]);                              \
    auto r0 = __builtin_amdgcn_permlane32_swap(a0, b0, false, false); auto r1 = __builtin_amdgcn_permlane32_swap(a1, b1, false, false); \
    u32x4 w = {r0[0], r1[0], r0[1], r1[1]}; OUT = *reinterpret_cast<bf16x8*>(&w); } while (0)
    PK4(p0, 0, pa0); PK4(p0, 8, pa1); PK4(p1, 0, pa2); PK4(p1, 8, pa3);
#undef PK4
}
typedef int i32x8a __attribute__((ext_vector_type(8)));
typedef int i32x4a __attribute__((ext_vector_type(4)));
__device__ __forceinline__ void qkt(f32x16& p0, f32x16& p1, const LAS unsigned char* Ks, const i32x8a* qr, int r32, int hi) {
    p0 = f32x16{}; p1 = f32x16{};
#pragma unroll
    for (int c = 0; c < 3; ++c) { const int cb = c * 64 + hi * 32;
        const i32x4a a0 = *(const LAS i32x4a*)(Ks + r32 * KROW + cb), a1 = *(const LAS i32x4a*)(Ks + r32 * KROW + cb + 16);
        const i32x4a b0 = *(const LAS i32x4a*)(Ks + (32 + r32) * KROW + cb), b1 = *(const LAS i32x4a*)(Ks + (32 + r32) * KROW + cb + 16);
        p0 = __builtin_amdgcn_mfma_scale_f32_32x32x64_f8f6f4(__builtin_shufflevector(a0, a1, 0, 1, 2, 3, 4, 5, 6, 7), qr[c], p0, 0, 0, 0, 0, 0, 0);
        p1 = __builtin_amdgcn_mfma_scale_f32_32x32x64_f8f6f4(__builtin_shufflevector(b0, b1, 0, 1, 2, 3, 4, 5, 6, 7), qr[c], p1, 0, 0, 0, 0, 0, 0); }
}
__device__ __forceinline__ int v_st(int k, int c) { const int kk = (k & ~0xC) | ((k & 4) << 1) | ((k & 8) >> 1); return ((kk >> 3) * 4 + (c >> 5)) * 512 + ((kk & 7) * 32 + (c & 31)) * 2; }
__device__ __forceinline__ int v_rd_base(int lane) { return ((lane & 3) << 3) | (((lane >> 2) & 3) << 6) | (((lane >> 4) & 1) << 5) | (((lane >> 5) & 1) << 8); }
constexpr int v_rd_off(int d0, int ks, int half) { return d0 * 512 + ks * 4096 + half * 2048; }
template <int OFF> __device__ __forceinline__ s16x4 tr_read(int vb) {
    s16x4 r; asm volatile("ds_read_b64_tr_b16 %0, %1 offset:%2" : "=&v"(r) : "v"(vb), "i"(OFF) : "memory"); return r;
}
template <int D0> __device__ __forceinline__ void pv_one(f32x16& od, int vb, bf16x8 pa0, bf16x8 pa1, bf16x8 pa2, bf16x8 pa3) {
    const s16x4 l0 = tr_read<v_rd_off(D0, 0, 0)>(vb), h0 = tr_read<v_rd_off(D0, 0, 1)>(vb), l1 = tr_read<v_rd_off(D0, 1, 0)>(vb), h1 = tr_read<v_rd_off(D0, 1, 1)>(vb);
    const s16x4 l2 = tr_read<v_rd_off(D0, 2, 0)>(vb), h2 = tr_read<v_rd_off(D0, 2, 1)>(vb), l3 = tr_read<v_rd_off(D0, 3, 0)>(vb), h3 = tr_read<v_rd_off(D0, 3, 1)>(vb);
    asm volatile("s_waitcnt lgkmcnt(0)" ::: "memory"); SBAR();
#define PK(L, H) (bf16x8){L[0], L[1], L[2], L[3], H[0], H[1], H[2], H[3]}
    od = __builtin_amdgcn_mfma_f32_32x32x16_bf16(pa0, PK(l0, h0), od, 0, 0, 0);
    od = __builtin_amdgcn_mfma_f32_32x32x16_bf16(pa1, PK(l1, h1), od, 0, 0, 0);
    od = __builtin_amdgcn_mfma_f32_32x32x16_bf16(pa2, PK(l2, h2), od, 0, 0, 0);
    od = __builtin_amdgcn_mfma_f32_32x32x16_bf16(pa3, PK(l3, h3), od, 0, 0, 0);
#undef PK
}
__device__ __forceinline__ void pv_d0(f32x16* o, int vb, bf16x8 pa0, bf16x8 pa1, bf16x8 pa2, bf16x8 pa3) {
    pv_one<0>(o[0], vb, pa0, pa1, pa2, pa3); pv_one<1>(o[1], vb, pa0, pa1, pa2, pa3); pv_one<2>(o[2], vb, pa0, pa1, pa2, pa3); pv_one<3>(o[3], vb, pa0, pa1, pa2, pa3);
}
struct VFrag { s16x4 l0, h0, l1, h1, l2, h2, l3, h3; };
template <int D0> __device__ __forceinline__ void pv_reads(VFrag& f, int vb) {
    f.l0 = tr_read<v_rd_off(D0, 0, 0)>(vb); f.h0 = tr_read<v_rd_off(D0, 0, 1)>(vb); f.l1 = tr_read<v_rd_off(D0, 1, 0)>(vb); f.h1 = tr_read<v_rd_off(D0, 1, 1)>(vb);
    f.l2 = tr_read<v_rd_off(D0, 2, 0)>(vb); f.h2 = tr_read<v_rd_off(D0, 2, 1)>(vb); f.l3 = tr_read<v_rd_off(D0, 3, 0)>(vb); f.h3 = tr_read<v_rd_off(D0, 3, 1)>(vb);
}
__device__ __forceinline__ void pv_mma(f32x16& od, const VFrag& f, bf16x8 pa0, bf16x8 pa1, bf16x8 pa2, bf16x8 pa3) {
#define PK(L, H) (bf16x8){L[0], L[1], L[2], L[3], H[0], H[1], H[2], H[3]}
    od = __builtin_amdgcn_mfma_f32_32x32x16_bf16(pa0, PK(f.l0, f.h0), od, 0, 0, 0);
    od = __builtin_amdgcn_mfma_f32_32x32x16_bf16(pa1, PK(f.l1, f.h1), od, 0, 0, 0);
    od = __builtin_amdgcn_mfma_f32_32x32x16_bf16(pa2, PK(f.l2, f.h2), od, 0, 0, 0);
    od = __builtin_amdgcn_mfma_f32_32x32x16_bf16(pa3, PK(f.l3, f.h3), od, 0, 0, 0);
#undef PK
}
__device__ __forceinline__ float sm_max(const f32x16& p0, const f32x16& p1) {
    float a = fmaxf(fmaxf(p0[0], p0[1]), p0[2]), b = fmaxf(fmaxf(p1[0], p1[1]), p1[2]);
#pragma unroll
    for (int r = 3; r < 15; r += 2) { a = fmaxf(fmaxf(a, p0[r]), p0[r + 1]); b = fmaxf(fmaxf(b, p1[r]), p1[r + 1]); }
    float pmax = fmaxf(fmaxf(a, b), fmaxf(p0[15], p1[15]));
    auto rr = __builtin_amdgcn_permlane32_swap(__float_as_uint(pmax), __float_as_uint(pmax), false, false);
    return fmaxf(__uint_as_float(rr[0]), __uint_as_float(rr[1]));
}
__device__ __forceinline__ void sm_scale(f32x16& p0, f32x16& p1, float pmax, float& m_reg, float& alpha) {
    constexpr float C = SCALE * 1.4426950408889634f; float mn;
    const bool keep = __all(pmax - m_reg <= THR / SCALE);
    mn = keep ? m_reg : fmaxf(m_reg, pmax); alpha = keep ? 1.f : __builtin_amdgcn_exp2f((m_reg - mn) * C); m_reg = mn;
    const float mnC = -mn * C; float cv = C; asm volatile("" : "+v"(cv));
#pragma unroll
    for (int r = 0; r < 16; ++r) { float a = p0[r], b = p1[r]; asm("v_fma_f32 %0, %0, %1, %2" : "+v"(a) : "v"(cv), "v"(mnC)); asm("v_fma_f32 %0, %0, %1, %2" : "+v"(b) : "v"(cv), "v"(mnC)); p0[r] = a; p1[r] = b; }
}
__device__ __forceinline__ void sm_exp(f32x16& p) {
#pragma unroll
    for (int r = 0; r < 16; ++r) p[r] = __builtin_amdgcn_exp2f(p[r]);
}
template <int VAR = 0>
__device__ __forceinline__ void attn_unit(const unsigned char* __restrict__ Qb, const unsigned char* __restrict__ Kh, const bf16_t* __restrict__ Vh, unsigned char* __restrict__ Ob, LAS unsigned char* lds, int wave_s) {
    const int lane = opq(lane_id()), wid = wave_s, tid = wid * 64 + lane, r32 = lane & 31, hi = lane >> 5;
    LAS unsigned char* V_lds = lds; LAS unsigned char* K_lds = lds + NST * SHM_V;
    LAS float* ws = (LAS float*)(lds + NST * SHM_V + NST * SHM_K) + wid * 64; LAS float* li_l = ws; LAS float* al_l = ws + 32;
    float m_reg = -1e30f, l_reg = 0; f32x16 o[4] = {}; i32x8a qr[3];
    const unsigned char* Qw = Qb + (size_t)(wid * QBLK + r32) * DQK + hi * 32;
#pragma unroll
    for (int c = 0; c < 3; ++c) { const i32x4a q0 = *(const i32x4a*)(Qw + c * 64), q1 = *(const i32x4a*)(Qw + c * 64 + 16); qr[c] = __builtin_shufflevector(q0, q1, 0, 1, 2, 3, 4, 5, 6, 7); }
    unsigned kofs[2], vofs[2];
#pragma unroll
    for (int sl = 0; sl < 2; ++sl) { const int p = 64 * (wid + 8 * sl) + lane, row = (p * 5042) >> 16, c = p - 13 * row;
        kofs[sl] = (unsigned)(row * DQK + (c < 12 ? c : 11) * 16);
        const int sub = p >> 5, within = p & 31, kk = (sub >> 2) * 8 + (within >> 2), cc = (sub & 3) * 32 + (within & 3) * 8, k = (kk & ~0xC) | ((kk & 4) << 1) | ((kk & 8) >> 1);
        vofs[sl] = (unsigned)(k * DV * 2 + cc * 2); }
    const int vb0 = (int)(uintptr_t)V_lds + v_rd_base(lane);
#define SDMA(k0, st) do { if constexpr (!(VAR & 16)) { \
    const char* kb_ = uni_ptr((const char*)Kh + (size_t)(k0) * DQK); asm volatile("" : "+s"(kb_)); const char* vg_ = uni_ptr((const char*)Vh + (size_t)(k0) * DV * 2); asm volatile("" : "+s"(vg_)); \
    LAS unsigned char* kd_ = K_lds + (st) * SHM_K + wid * 1024; LAS unsigned char* vd_ = V_lds + (st) * SHM_V + wid * 1024; \
    __builtin_amdgcn_global_load_lds((const unsigned*)(kb_ + kofs[0]), (LAS unsigned*)kd_, 16, 0, 0); \
    if (wid < 5) __builtin_amdgcn_global_load_lds((const unsigned*)(kb_ + kofs[1]), (LAS unsigned*)(kd_ + 8192), 16, 0, 0); \
    __builtin_amdgcn_global_load_lds((const unsigned*)(vg_ + vofs[0]), (LAS unsigned*)vd_, 16, 0, 0); \
    __builtin_amdgcn_global_load_lds((const unsigned*)(vg_ + vofs[1]), (LAS unsigned*)(vd_ + 8192), 16, 0, 0); } } while (0)
#define SWAIT() asm volatile("s_waitcnt vmcnt(0)" ::: "memory")
#define RESC(a) do { if (__any((a) < 1.f)) { if (hi == 0) al_l[r32] = (a); asm volatile("s_waitcnt lgkmcnt(0)" ::: "memory"); \
    _Pragma("unroll") for (int d = 0; d < 4; ++d) _Pragma("unroll") for (int r = 0; r < 16; ++r) o[d][r] *= al_l[crow(r, hi)]; } } while (0)
    f32x16 pA0, pA1, pB0, pB1; float mnA, alA, alB; bf16x8 pa0, pa1, pa2, pa3; constexpr int NTL = SKV / KVBLK;
    SDMA(0, 0); SDMA(KVBLK, 1); SWAIT(); __syncthreads();
    qkt(pA0, pA1, K_lds, qr, r32, hi); partialSM(pA0, pA1, m_reg, mnA, alA);
    VFrag fa, fb; float pmx;
    int sV = 0, sK = 1, sW = 2;
#define WAITF(n, f) asm volatile("s_waitcnt lgkmcnt(" #n ")" : "+v"(f.l0), "+v"(f.h0), "+v"(f.l1), "+v"(f.h1), "+v"(f.l2), "+v"(f.h2), "+v"(f.l3), "+v"(f.h3) :: "memory")
#define PKB(L, H) (bf16x8){L[0], L[1], L[2], L[3], H[0], H[1], H[2], H[3]}
#define MM(OD, PA, L, H) do { if constexpr (!(VAR & 2)) OD = __builtin_amdgcn_mfma_f32_32x32x16_bf16(PA, PKB(L, H), OD, 0, 0, 0); SBAR(); } while (0)
#define SL(...) do { __VA_ARGS__; SBAR(); } while (0)
#define MAX3(a, x, y) a = fmaxf(fmaxf(a, x), y)
#define PIN1(x) asm volatile("" : "+v"(x))
#define PINV(P) asm volatile("" : "+v"(P))
#define FM(P, r) do { float t_ = P[r]; asm volatile("v_fma_f32 %0, %0, %1, %2" : "+v"(t_) : "v"(cvm_), "v"(mnc_)); P[r] = t_; } while (0)
#define EX(P, r) do { if constexpr (!(VAR & 1)) P[r] = __builtin_amdgcn_exp2f(P[r]); } while (0)
    constexpr float CSM = SCALE * 1.4426950408889634f; float cvm_ = CSM; asm volatile("" : "+v"(cvm_)); float ma_, mb_, mnc_;
#define TILE(PN0, PN1, PO0, PO1, ALO, ALN, NEXTK0) do { \
        SBAR(); SDMA(NEXTK0, sW); SBAR(); \
        const int vb_ = vb0 + sV * SHM_V; \
        if constexpr (!(VAR & 4)) qkt(PN0, PN1, K_lds + sK * SHM_K, qr, r32, hi); else { PN0 = f32x16{}; PN1 = f32x16{}; asm volatile("" : "+v"(PN0), "+v"(PN1)); } \
        pv_reads<0>(fa, vb_); \
        finishSM<VAR>(PO0, PO1, ALO, l_reg, pa0, pa1, pa2, pa3); SBAR(); \
          \
        pv_reads<1>(fb, vb_); WAITF(8, fa); \
        MM(o[0], pa0, fa.l0, fa.h0); SL(ma_ = fmaxf(fmaxf(PN0[0], PN0[1]), PN0[2]); MAX3(ma_, PN0[3], PN0[4]); MAX3(ma_, PN0[5], PN0[6]); MAX3(ma_, PN0[7], PN0[8]); MAX3(ma_, PN0[9], PN0[10]); MAX3(ma_, PN0[11], PN0[12]); PIN1(ma_)); \
        MM(o[0], pa1, fa.l1, fa.h1); SL(MAX3(ma_, PN0[13], PN0[14]); mb_ = fmaxf(fmaxf(PN0[15], PN1[0]), PN1[1]); MAX3(mb_, PN1[2], PN1[3]); MAX3(mb_, PN1[4], PN1[5]); MAX3(mb_, PN1[6], PN1[7]); MAX3(mb_, PN1[8], PN1[9]); PIN1(ma_); PIN1(mb_)); \
        MM(o[0], pa2, fa.l2, fa.h2); SL(MAX3(mb_, PN1[10], PN1[11]); MAX3(mb_, PN1[12], PN1[13]); MAX3(mb_, PN1[14], PN1[15]); pmx = fmaxf(ma_, mb_); \
            { auto rr_ = __builtin_amdgcn_permlane32_swap(__float_as_uint(pmx), __float_as_uint(pmx), false, false); pmx = fmaxf(__uint_as_float(rr_[0]), __uint_as_float(rr_[1])); } PIN1(pmx)); \
        MM(o[0], pa3, fa.l3, fa.h3); SL({ const bool keep_ = __all(pmx - m_reg <= THR / SCALE); const float mn_ = keep_ ? m_reg : fmaxf(m_reg, pmx); ALN = keep_ ? 1.f : __builtin_amdgcn_exp2f((m_reg - mn_) * CSM); m_reg = mn_; mnc_ = -mn_ * CSM; } PIN1(mnc_); PIN1(ALN)); \
        pv_reads<2>(fa, vb_); WAITF(8, fb); \
        MM(o[1], pa0, fb.l0, fb.h0); SL(FM(PN0, 0); FM(PN0, 1); FM(PN0, 2); FM(PN0, 3); FM(PN0, 4); FM(PN0, 5)); \
        MM(o[1], pa1, fb.l1, fb.h1); SL(FM(PN0, 6); FM(PN0, 7); FM(PN0, 8); FM(PN0, 9); FM(PN0, 10); FM(PN0, 11)); \
        MM(o[1], pa2, fb.l2, fb.h2); SL(FM(PN0, 12); FM(PN0, 13); FM(PN0, 14); FM(PN0, 15); FM(PN1, 0)); \
        MM(o[1], pa3, fb.l3, fb.h3); SL(FM(PN1, 1); FM(PN1, 2); FM(PN1, 3); FM(PN1, 4); FM(PN1, 5)); \
        pv_reads<3>(fb, vb_); WAITF(8, fa); \
        MM(o[2], pa0, fa.l0, fa.h0); SL(FM(PN1, 6); FM(PN1, 7); FM(PN1, 8); FM(PN1, 9); FM(PN1, 10)); \
        MM(o[2], pa1, fa.l1, fa.h1); SL(FM(PN1, 11); FM(PN1, 12); FM(PN1, 13); FM(PN1, 14); FM(PN1, 15)); \
        MM(o[2], pa2, fa.l2, fa.h2); SL(EX(PN0, 0); EX(PN0, 1); EX(PN0, 2); PINV(PN0)); \
        MM(o[2], pa3, fa.l3, fa.h3); SL(EX(PN0, 3); EX(PN0, 4); EX(PN0, 5); PINV(PN0)); \
        WAITF(0, fb); \
        MM(o[3], pa0, fb.l0, fb.h0); SL(EX(PN0, 6); EX(PN0, 7); EX(PN0, 8); PINV(PN0)); \
        MM(o[3], pa1, fb.l1, fb.h1); SL(EX(PN0, 9); EX(PN0, 10); EX(PN0, 11); PINV(PN0)); \
        MM(o[3], pa2, fb.l2, fb.h2); SL(EX(PN0, 12); EX(PN0, 13); PINV(PN0)); \
        MM(o[3], pa3, fb.l3, fb.h3); SL(EX(PN0, 14); EX(PN0, 15); PINV(PN0)); \
        asm volatile("" : "+v"(PN0), "+v"(PN1)); SBAR(); \
        RESC(ALN); SWAIT(); if constexpr (!(VAR & 8)) __syncthreads(); \
        sV = sK; sK = sW; sW = sW == NST - 1 ? 0 : sW + 1; } while (0)
    for (int j = 1; j + 1 < NTL; j += 2) {
        TILE(pB0, pB1, pA0, pA1, alA, alB, (j + 1) * KVBLK);
        TILE(pA0, pA1, pB0, pB1, alB, alA, (j + 2) * KVBLK);
    }
#undef TILE
#undef WAITF
#undef PKB
#undef MM
#undef SL
#undef MAX3
#undef PIN1
#undef PINV
#undef FM
#undef EX
    SBAR(); qkt(pB0, pB1, K_lds + sK * SHM_K, qr, r32, hi);
    finishSM(pA0, pA1, alA, l_reg, pa0, pa1, pa2, pa3); SBAR();
    pv_d0(o, vb0 + sV * SHM_V, pa0, pa1, pa2, pa3); partialSM(pB0, pB1, m_reg, mnA, alB);
    RESC(alB);
    finishSM(pB0, pB1, alB, l_reg, pa0, pa1, pa2, pa3); SBAR();
    pv_d0(o, vb0 + sK * SHM_V, pa0, pa1, pa2, pa3);
    if (hi == 0) li_l[r32] = l_reg; asm volatile("s_waitcnt lgkmcnt(0)" ::: "memory");
    float rli[16];
#pragma unroll
    for (int r = 0; r < 16; ++r) rli[r] = __builtin_amdgcn_rcpf(li_l[crow(r, hi)]);
    __syncthreads();
    const int tid2 = opq(tid), wid2 = tid2 >> 6, lane2 = tid2 & 63, r32b = lane2 & 31, hib = lane2 >> 5;
    LAS unsigned char* ost = lds + wid2 * 4096;
#pragma unroll
    for (int r = 0; r < 16; ++r) { const int orow = crow(r, hib);
#pragma unroll
        for (int d0 = 0; d0 < 4; ++d0) { const float v = clamp8(o[d0][r] * rli[r] * 64.0f); ost[orow * 128 + d0 * 32 + r32b] = (unsigned char)(__builtin_amdgcn_cvt_pk_fp8_f32(v, v, 0, false) & 0xff); } }
    asm volatile("s_waitcnt lgkmcnt(0)" ::: "memory");
    unsigned char* Ow = Ob + (size_t)(wid2 * QBLK) * 1024;
#pragma unroll
    for (int i = 0; i < 4; ++i) { const int id = lane2 + 64 * i, rr = id >> 3, ch = id & 7;
        const u32x4 w = *(const LAS u32x4*)(ost + rr * 128 + ch * 16);
        gst16(Ow + (size_t)rr * 1024 + ch * 16, (u32x4)(w)); }
#undef SDMA
#undef SWAIT
#undef RESC
}
}

struct Frame {
    LAS unsigned char* lds; LAS unsigned char* misc;
    unsigned* ctl; unsigned char* ws;
    int tid, lane, wave, vcu, G;
    const float* in[25];
    float* out;
};
struct Args { const float* in[25]; float* out; unsigned char* ws; int ph_lo, ph_hi; };

__device__ __forceinline__ void transpose_item(const float* W, int N, int K, bf16_t* WT, int k0, int n0, int rbase, bool perm, const float* kscale, LAS float* scr, int lane) {
#pragma unroll 8
    for (int i = 0; i < 32; ++i) { const int kk = 2 * i + (lane >> 5); float v = W[(size_t)(k0 + kk) * N + n0 + (lane & 31)]; if (kscale) v *= kscale[k0 + kk]; scr[kk * 33 + (lane & 31)] = v; }
    LDS_WAIT(); asm volatile("" ::: "memory");
    const int c = lane & 7;
#pragma unroll
    for (int j = 0; j < 4; ++j) { const int n = (lane >> 3) + 8 * j; const LAS float* s = scr + (8 * c) * 33 + n;
        u32x4 o; o.x = pk2(s[0 * 33], s[1 * 33]); o.y = pk2(s[2 * 33], s[3 * 33]); o.z = pk2(s[4 * 33], s[5 * 33]); o.w = pk2(s[6 * 33], s[7 * 33]);
        const int orow = rbase + (perm ? pg8::perm32(n) : n);
        gst16(WT + (size_t)orow * K + k0 + 8 * c, (u32x4)(o)); }
    LDS_WAIT(); asm volatile("" ::: "memory");
}

struct T8Item { const float* W; unsigned char* WT; int N, K, k0, n0, rbase, perm; const float* kscale; };
__device__ __forceinline__ void t8_load(const T8Item& it, f32x4 (&v)[16], int lane) {
    const int kr = lane >> 3, nq = (lane & 7) * 4;
#pragma unroll
    for (int i = 0; i < 16; ++i) v[i] = __builtin_nontemporal_load((const f32x4*)(it.W + (size_t)(it.k0 + 8 * i + kr) * it.N + it.n0 + nq));
}
__device__ __forceinline__ void t8_finish(const T8Item& it, const f32x4 (&v)[16], float qs, LAS float* scr, int lane) {
    const int kr = lane >> 3, nq = (lane & 7) * 4;
#pragma unroll
    for (int i = 0; i < 16; ++i) { LAS float* d = scr + (8 * i + kr) * 33 + nq; d[0] = v[i].x; d[1] = v[i].y; d[2] = v[i].z; d[3] = v[i].w; }
    LDS_WAIT(); asm volatile("" ::: "memory");
    const int c = lane & 7;
#pragma unroll
    for (int j = 0; j < 4; ++j) { const int n = (lane >> 3) + 8 * j; const LAS float* s = scr + (16 * c) * 33 + n;
        u32x4 o;
#pragma unroll
        for (int q = 0; q < 4; ++q) { f32x4 v = (f32x4){s[(4 * q) * 33], s[(4 * q + 1) * 33], s[(4 * q + 2) * 33], s[(4 * q + 3) * 33]} * qs; if (it.kscale) v = v * *(const f32x4*)(it.kscale + it.k0 + 16 * c + 4 * q); o[q] = pk_fp8x4(v); }
        int orow;
        if (it.perm == 2) { const int a = (it.n0 & 255) + n;
            orow = (it.n0 & ~255) + 128 * ((a >> 3) & 1) + 32 * (a >> 6) + 8 * ((a >> 4) & 3) + (a & 7); }
        else orow = it.rbase + (it.perm ? pg8::perm32(n) : n);
        gst16(it.WT + (size_t)orow * it.K + it.k0 + 16 * c, (u32x4)(o)); }
    LDS_WAIT(); asm volatile("" ::: "memory");
}
constexpr int I_GU8L = 32 * 8 * 64, I_DN8L = 32 * 8 * 32;
__device__ __forceinline__ T8Item t8_item(const Frame& F, int layer, int j) {
    T8Item it;
    if (j < I_GU8L) { const int r = layer * I_GU8L + j, mat = r / (8 * 64), q = r % (8 * 64), kb = q / 64, nb = q % 64, n0 = nb * 32;
        it.W = F.in[20] + (size_t)mat * 1024 * 2048; it.WT = F.ws + WS_WGU + (size_t)mat * 2048 * 1024; it.N = 2048; it.K = 1024; it.k0 = kb * 128; it.n0 = n0;
        it.rbase = ((n0 & 1023) >> 7) * 256 + (n0 >> 10) * 128 + (n0 & 127); it.perm = 0; it.kscale = nullptr; }
    else { const int r = layer * I_DN8L + (j - I_GU8L), mat = r / (8 * 32), q = r % (8 * 32), kb = q / 32, nb = q % 32;
        it.W = F.in[22] + (size_t)mat * 1024 * 1024; it.WT = F.ws + WS_WDN + (size_t)mat * 1024 * 1024; it.N = 1024; it.K = 1024; it.k0 = kb * 128; it.n0 = nb * 32; it.rbase = nb * 32; it.perm = 2; it.kscale = nullptr; }
    return it;
}
__device__ __forceinline__ void convert_experts(Frame& F, int layer, int j0, int j1, int bi, int nb) {
    const int lane = opq(lane_id());
    LAS float* scr = (LAS float*)(F.lds + F.wave * 16896);
    const int gw = bi * NWAVES + F.wave, NGW = nb * NWAVES;
    const int NBIG = j1;
    int it = j0 + gw; f32x4 va[16], vb[16]; T8Item ia, ib;
    if (it < NBIG) { ia = t8_item(F, layer, it); t8_load(ia, va, lane); }
    while (it < NBIG) {
        const int itn = it + NGW; if (itn < NBIG) { ib = t8_item(F, layer, itn); t8_load(ib, vb, lane); }
        t8_finish(ia, va, 64.f, scr, lane);
        it = itn; if (it >= NBIG) break;
        const int itn2 = it + NGW; if (itn2 < NBIG) { ia = t8_item(F, layer, itn2); t8_load(ia, va, lane); }
        t8_finish(ib, vb, 64.f, scr, lane);
        it = itn2; }
}

__device__ __forceinline__ void p0_prologue(Frame& F) {
    const float* c_in = F.in[1]; const float* cctx = F.in[3]; const float* ada_w = F.in[4]; const float* ada_b = F.in[5];
    float* modv = (float*)(F.ws + WS_MODV);
    if (F.vcu < 192) {
        LAS float* s = (LAS float*)F.lds;
        { float cv[18];
          const int tq = opq(F.tid);
#pragma unroll
          for (int j = 0; j < 18; ++j) { const int k = (tq + j * NTHR) & 1023; cv[j] = (j >> 1) < 8 ? c_in[(j >> 1) * 1024 + k] : cctx[k]; }
          __builtin_amdgcn_sched_barrier(0);
#pragma unroll
          for (int j = 0; j < 18; ++j) { const float v = cv[j]; s[F.tid + j * NTHR] = v / (1.0f + expf(-v)); } }
        __syncthreads();
        const int ln = opq(F.lane);
        const int col0 = F.vcu * 64, layer = col0 / 6144, nb = col0 % 6144, c16 = ln & 15, kq = ln >> 4;
        const float* wp = ada_w + (size_t)layer * 1024 * 6144 + nb + 4 * c16 + (size_t)(F.wave * 128 + kq) * 6144;
        f32x4 a[9];
#pragma unroll
        for (int b = 0; b < 9; ++b) a[b] = (f32x4){0.f, 0.f, 0.f, 0.f};
        const LAS float* sp = s + F.wave * 128 + kq;
#pragma unroll
        for (int hf = 0; hf < 2; ++hf) { f32x4 w[16];
#pragma unroll
            for (int i = 0; i < 16; ++i) w[i] = __builtin_nontemporal_load((const f32x4*)(wp + (size_t)(4 * (16 * hf + i)) * 6144));
            __builtin_amdgcn_sched_barrier(0);
#pragma unroll
            for (int i = 0; i < 16; ++i) {
#pragma unroll
                for (int b = 0; b < 9; ++b) a[b] += w[i] * sp[b * 1024 + 4 * (16 * hf + i)]; }
            __builtin_amdgcn_sched_barrier(0); }
        LAS float* red = (LAS float*)(F.lds + 40960);
#pragma unroll
        for (int b = 0; b < 9; ++b) *(LAS f32x4*)(red + ((F.wave * 4 + kq) * 9 + b) * 64 + 4 * c16) = a[b];
        __syncthreads();
        for (int i = F.tid; i < 9 * 64; i += NTHR) { const int b = i >> 6, l = i & 63; float t = 0.f;
#pragma unroll
            for (int p = 0; p < 32; ++p) t += red[(p * 9 + b) * 64 + l];
            const int nn = nb + l; modv[((size_t)layer * 9 + b) * 6144 + nn] = t + ada_b[layer * 6144 + nn]; }
        __syncthreads();
    }
    if (F.vcu == 192) {
        f32x2* rope = (f32x2*)(F.ws + WS_ROPE);
        for (int i = F.tid; i < 64 * 16; i += NTHR) { const int p = i >> 4, f = i & 15;
            double invf = 1.0; for (int q = 0; q < f; ++q) invf *= 0.56234132519034908;
            const double x = (double)p * invf, kk = __builtin_rint(x * 0.15915494309189535), r = (x - kk * 6.2831853071795862) , r2 = r * r;
            double sn = 0.0, cs = 0.0, ts = r, tc = 1.0;
#pragma unroll
            for (int n = 0; n < 14; ++n) { sn += ts; cs += tc; tc = -tc * r2 * (1.0 / (double)((2 * n + 1) * (2 * n + 2))); ts = -ts * r2 * (1.0 / (double)((2 * n + 2) * (2 * n + 3))); }
            rope[i] = (f32x2){(float)cs, (float)sn}; }
    }
    if (F.vcu >= 193 && F.vcu < 201) {
        const float* rw = F.in[18]; float* rwt = (float*)(F.ws + WS_RWT); const int g = (F.vcu - 193) * NTHR + opq(F.tid); float v[16];
#pragma unroll
        for (int j = 0; j < 16; ++j) v[j] = rw[g + 4096 * j];
#pragma unroll
        for (int j = 0; j < 16; ++j) { const int i = g + 4096 * j; rwt[(size_t)(i >> 15) * 32768 + (i & 31) * 1024 + ((i >> 5) & 1023)] = v[j]; }
    }
    if (F.vcu >= 201 && F.vcu < 209) {
        u32x4* z = (u32x4*)(F.ws + WS_WP1 + (size_t)832 * 1024);
        for (int i = (F.vcu - 201) * NTHR + F.tid; i < 192 * 64; i += 8 * NTHR) z[i] = (u32x4){0u, 0u, 0u, 0u};
    }
    if (F.vcu <= 192) return;
    LAS float* scr = (LAS float*)(F.lds + F.wave * 16896);
    const int gw = (F.vcu - 193) * NWAVES + F.wave, NGW = (F.G - 193) * NWAVES;
    constexpr int I_POOL = 4 * 4 * 8, I_DQ = 8 * 16, I_DKV = 8 * 10, I_UQ = 4 * 48, I_UKV = 2 * 64, I_WO = 8 * 32;
    constexpr int NITEMS = I_POOL + I_DQ + I_DKV + I_UQ + I_UKV + I_WO;
    for (int it = gw; it < NITEMS; it += NGW) {
        int r = it;
        if (r < I_POOL) { const int g = r / 32, q = r % 32, kb = q / 8, nb = q % 8;
            transpose_item(F.in[8] + (size_t)g * 256 * 256, 256, 256, (bf16_t*)(F.ws + WS_WPOOL) + (size_t)g * 256 * 256, kb * 64, nb * 32, nb * 32, false, nullptr, scr, F.lane); continue; } r -= I_POOL;
        if (r < I_DQ) { const int kb = r / 16, nb = r % 16; f32x4 vv[16];
            T8Item wi; wi.W = F.in[11]; wi.WT = F.ws + WS_WP1; wi.N = 512; wi.K = 1024; wi.k0 = kb * 128; wi.n0 = nb * 32; wi.rbase = nb * 32; wi.perm = 0; wi.kscale = nullptr;
            t8_load(wi, vv, F.lane); t8_finish(wi, vv, 64.f, scr, F.lane); continue; } r -= I_DQ;
        if (r < I_DKV) { const int kb = r / 10, nb = r % 10; f32x4 vv[16];
            T8Item wi; wi.W = F.in[14]; wi.WT = F.ws + WS_WP1; wi.N = 320; wi.K = 1024; wi.k0 = kb * 128; wi.n0 = nb * 32; wi.rbase = 512 + nb * 32; wi.perm = nb >= 8; wi.kscale = nullptr;
            t8_load(wi, vv, F.lane); t8_finish(wi, vv, 64.f, scr, F.lane); continue; } r -= I_DKV;
        if (r < I_UQ) { const int kb = r / 48, nb = r % 48; f32x4 vv[16];
            T8Item wi; wi.W = F.in[13]; wi.WT = F.ws + WS_WUQ; wi.N = 1536; wi.K = 512; wi.k0 = kb * 128; wi.n0 = nb * 32; wi.rbase = nb * 32; wi.perm = (nb % 6) >= 4; wi.kscale = F.in[12];
            t8_load(wi, vv, F.lane); t8_finish(wi, vv, 64.f, scr, F.lane); continue; } r -= I_UQ;
        if (r < I_UKV) { const int kb = r / 64, nb = r % 64; f32x4 vv[16];
            T8Item wi; wi.W = F.in[16]; wi.WT = F.ws + WS_WUKV; wi.N = 2048; wi.K = 256; wi.k0 = kb * 128; wi.n0 = nb * 32; wi.rbase = nb * 32; wi.perm = 0; wi.kscale = F.in[15];
            t8_load(wi, vv, F.lane); t8_finish(wi, vv, 64.f, scr, F.lane); continue; } r -= I_UKV;
        { const int kb = r / 32, nb = r % 32; f32x4 vv[16];
            T8Item wi; wi.W = F.in[17]; wi.WT = F.ws + WS_WO; wi.N = 1024; wi.K = 1024; wi.k0 = kb * 128; wi.n0 = nb * 32; wi.rbase = nb * 32; wi.perm = 0; wi.kscale = nullptr;
            t8_load(wi, vv, F.lane); t8_finish(wi, vv, 64.f, scr, F.lane); }
    }
}

__device__ __forceinline__ const float* xrow_ptr(const Frame& F, int row) { return row < NL ? F.in[0] + (size_t)row * D : F.in[2] + (size_t)(row - NL) * D; }

template <int W> __device__ __forceinline__ f32x4 win_sum(const Frame& F, const LAS float* rinv_l, int rbase, int base, int t, int Lseq, int col, int& cnt) {
    f32x4 v[W]; float w[W]; cnt = 0;
#pragma unroll
    for (int i = 0; i < W; ++i) { const int tt = t - W / 2 + i; const bool ok = tt >= 0 && tt < Lseq; const int tc = tt < 0 ? 0 : (tt >= Lseq ? Lseq - 1 : tt); const int rr = base + tc;
        v[i] = *(const f32x4*)(xrow_ptr(F, rr) + col); w[i] = ok ? rinv_l[rr - rbase] : 0.f; cnt += ok ? 1 : 0; }
    f32x4 s = (f32x4){0.f, 0.f, 0.f, 0.f};
#pragma unroll
    for (int i = 0; i < W; ++i) s += v[i] * w[i];
    return s;
}
__device__ __forceinline__ void p1_pooldiff(Frame& F) {
    const int rpb = (NT + F.G - 1) / F.G, r0 = F.vcu * rpb, r1 = min(NT, r0 + rpb);
    if (r0 >= r1) return;
    const int h0 = max(0, r0 - 8), h1 = min(NT, r1 + 8);
    LAS float* rinv_l = (LAS float*)(F.misc + M_RINV);
    for (int row = h0 + F.wave; row < h1; row += NWAVES) {
        const f32x4* xr = (const f32x4*)xrow_ptr(F, row) + F.lane; float s = 0.f;
#pragma unroll
        for (int j = 0; j < 4; ++j) { const f32x4 v = xr[64 * j]; s += (v.x * v.x + v.y * v.y) + (v.z * v.z + v.w * v.w); }
        s = wave_sum(s);
        if (F.lane == 0) rinv_l[row - h0] = 1.0f / sqrtf(s * (1.0f / D) + EPS);
    }
    __syncthreads();
    const float* ng = F.in[6];
    const float* modv = (const float*)(F.ws + WS_MODV);
    bf16_t* H = (bf16_t*)(F.ws + WS_H);
    const int rpw = (r1 - r0 + NWAVES - 1) / NWAVES, ra = r0 + rpw * F.wave, rb = min(r1, ra + rpw);
    f32x4 S[4] = {{0.f, 0.f, 0.f, 0.f}, {0.f, 0.f, 0.f, 0.f}, {0.f, 0.f, 0.f, 0.f}, {0.f, 0.f, 0.f, 0.f}}; int cnt[4] = {1, 1, 1, 1};
    for (int row = ra; row < rb; ++row) {
        int bidx, t, Lseq;
        if (row < NL) { bidx = row >> 11; t = row & 2047; Lseq = SEQ; } else { bidx = 8; t = (row - NL) & 255; Lseq = CTXL; }
        const int base = row - t; const float* xs = xrow_ptr(F, row);
        const float* s1 = modv + (bidx * 6 + 1) * 1024;
        const float rself = rinv_l[row - h0];
        f32x4 self[4];
#pragma unroll
        for (int j = 0; j < 4; ++j) self[j] = *(const f32x4*)(xs + 256 * j + 4 * F.lane);
        if (row == ra || t == 0) {
            S[0] = win_sum<2>(F, rinv_l, h0, base, t, Lseq, 4 * F.lane, cnt[0]);
            S[1] = win_sum<4>(F, rinv_l, h0, base, t, Lseq, 256 + 4 * F.lane, cnt[1]);
            S[2] = win_sum<8>(F, rinv_l, h0, base, t, Lseq, 512 + 4 * F.lane, cnt[2]);
            S[3] = win_sum<16>(F, rinv_l, h0, base, t, Lseq, 768 + 4 * F.lane, cnt[3]);
        } else {
            f32x4 va[4], vr[4]; float wa[4], wr_[4];
#pragma unroll
            for (int j = 0; j < 4; ++j) { const int hw = 1 << j;
                const int ta = t + hw - 1, tr = t - 1 - hw; const bool oka = ta < Lseq, okr = tr >= 0;
                const int rra = base + (oka ? ta : Lseq - 1), rrr = base + (okr ? tr : 0);
                va[j] = *(const f32x4*)(xrow_ptr(F, rra) + 256 * j + 4 * F.lane); vr[j] = *(const f32x4*)(xrow_ptr(F, rrr) + 256 * j + 4 * F.lane);
                wa[j] = oka ? rinv_l[rra - h0] : 0.f; wr_[j] = okr ? rinv_l[rrr - h0] : 0.f; cnt[j] += (oka ? 1 : 0) - (okr ? 1 : 0); }
#pragma unroll
            for (int j = 0; j < 4; ++j) S[j] += va[j] * wa[j] - vr[j] * wr_[j];
        }
#pragma unroll
        for (int j = 0; j < 4; ++j) { const int col = 256 * j + 4 * F.lane;
            const f32x4 gg = *(const f32x4*)(ng + col) * (*(const f32x4*)(s1 + col) + 1.0f);
            const f32x4 d = (S[j] * (1.0f / (float)cnt[j]) - self[j] * rself) * gg;
            u32x2 w; w.x = pk2(d.x, d.y); w.y = pk2(d.z, d.w);
            *(u32x2*)(H + (size_t)row * D + col) = w; }
    }
}

constexpr int DT_LD = 264, DT_TILE = 72 * DT_LD;
__device__ __forceinline__ void pool_block(Frame& F, bf16_t* X1) {
    const int rpb = (NT + F.G - 1) / F.G, r0 = F.vcu * rpb, r1 = min(NT, r0 + rpb), nr = r1 - r0;
    if (nr <= 0) return;
    const int h0 = max(0, r0 - 8), h1 = min(NT, r1 + 8);
    LAS float* rinv_l = (LAS float*)(F.misc + M_RINV);
    LAS bf16_t* dt = (LAS bf16_t*)F.lds;
    for (int rb = h0 + F.wave; rb < h1; rb += 6 * NWAVES) {
        f32x4 v[6][4];
#pragma unroll
        for (int q = 0; q < 6; ++q) { const int row = min(rb + q * NWAVES, h1 - 1); const f32x4* xr = (const f32x4*)xrow_ptr(F, row) + F.lane;
#pragma unroll
            for (int j = 0; j < 4; ++j) v[q][j] = xr[64 * j]; }
        __builtin_amdgcn_sched_barrier(0);
#pragma unroll
        for (int q = 0; q < 6; ++q) { const int row = rb + q * NWAVES; float s = 0.f;
#pragma unroll
            for (int j = 0; j < 4; ++j) s += (v[q][j].x * v[q][j].x + v[q][j].y * v[q][j].y) + (v[q][j].z * v[q][j].z + v[q][j].w * v[q][j].w);
            s = wave_sum(s);
            if (row < h1 && F.lane == 0) rinv_l[row - h0] = 1.0f / sqrtf(s * (1.0f / D) + EPS); }
    }
    __syncthreads();
    const float* ng = F.in[6]; const float* pb = F.in[9]; const float* ps = F.in[10];
    const float* modv = (const float*)(F.ws + WS_MODV);
    const bf16_t* Wp = (const bf16_t*)(F.ws + WS_WPOOL);
    const int lane = F.lane, n16 = lane & 15, kq = lane >> 4;
    { const int rpw = (nr + NWAVES - 1) / NWAVES, ra = r0 + rpw * F.wave, rb = min(r1, ra + rpw);
      f32x4 S[4] = {{0.f, 0.f, 0.f, 0.f}, {0.f, 0.f, 0.f, 0.f}, {0.f, 0.f, 0.f, 0.f}, {0.f, 0.f, 0.f, 0.f}}; int cnt[4] = {1, 1, 1, 1};
      for (int row = ra; row < rb; ++row) {
        int bidx, t, Lseq;
        if (row < NL) { bidx = row >> 11; t = row & 2047; Lseq = SEQ; } else { bidx = 8; t = (row - NL) & 255; Lseq = CTXL; }
        const int base = row - t; const float* xs = xrow_ptr(F, row);
        const float* s1 = modv + (bidx * 6 + 1) * 1024;
        const float rself = rinv_l[row - h0];
        f32x4 self[4];
#pragma unroll
        for (int j = 0; j < 4; ++j) self[j] = *(const f32x4*)(xs + 256 * j + 4 * lane);
        if (row == ra || t == 0) {
            S[0] = win_sum<2>(F, rinv_l, h0, base, t, Lseq, 4 * lane, cnt[0]);
            S[1] = win_sum<4>(F, rinv_l, h0, base, t, Lseq, 256 + 4 * lane, cnt[1]);
            S[2] = win_sum<8>(F, rinv_l, h0, base, t, Lseq, 512 + 4 * lane, cnt[2]);
            S[3] = win_sum<16>(F, rinv_l, h0, base, t, Lseq, 768 + 4 * lane, cnt[3]);
        } else {
            f32x4 va[4], vr[4]; float wa[4], wr_[4];
#pragma unroll
            for (int j = 0; j < 4; ++j) { const int hw = 1 << j;
                const int ta = t + hw - 1, tr = t - 1 - hw; const bool oka = ta < Lseq, okr = tr >= 0;
                const int rra = base + (oka ? ta : Lseq - 1), rrr = base + (okr ? tr : 0);
                va[j] = *(const f32x4*)(xrow_ptr(F, rra) + 256 * j + 4 * lane); vr[j] = *(const f32x4*)(xrow_ptr(F, rrr) + 256 * j + 4 * lane);
                wa[j] = oka ? rinv_l[rra - h0] : 0.f; wr_[j] = okr ? rinv_l[rrr - h0] : 0.f; cnt[j] += (oka ? 1 : 0) - (okr ? 1 : 0); }
#pragma unroll
            for (int j = 0; j < 4; ++j) S[j] += va[j] * wa[j] - vr[j] * wr_[j];
        }
#pragma unroll
        for (int j = 0; j < 4; ++j) { const int col = 256 * j + 4 * lane;
            const f32x4 gg = *(const f32x4*)(ng + col) * (*(const f32x4*)(s1 + col) + 1.0f);
            const f32x4 d = (S[j] * (1.0f / (float)cnt[j]) - self[j] * rself) * gg;
            u32x2 w; w.x = pk2(d.x, d.y); w.y = pk2(d.z, d.w);
            *(LAS u32x2*)(dt + j * DT_TILE + (row - r0) * DT_LD + 4 * lane) = w; } } }
    __syncthreads();
#pragma nounroll
    for (int g = 0; g < 4; ++g) {
        bf16x8 af[8][2];
        { const bf16_t* wa = Wp + (size_t)g * 256 * 256 + (size_t)(F.wave * 32 + n16) * 256 + kq * 8;
#pragma unroll
          for (int ks = 0; ks < 8; ++ks) { af[ks][0] = *(const bf16x8*)(wa + ks * 32); af[ks][1] = *(const bf16x8*)(wa + 16 * 256 + ks * 32); } }
        f32x4 acc[5][2];
#pragma unroll
        for (int tt = 0; tt < 5; ++tt) { acc[tt][0] = (f32x4){0.f, 0.f, 0.f, 0.f}; acc[tt][1] = acc[tt][0]; }
        const LAS bf16_t* db = dt + g * DT_TILE + n16 * DT_LD + kq * 8;
#pragma unroll
        for (int ks = 0; ks < 8; ++ks) {
#pragma unroll
            for (int tt = 0; tt < 5; ++tt) { const bf16x8 b = *(const LAS bf16x8*)(db + tt * 16 * DT_LD + ks * 32);
                acc[tt][0] = __builtin_amdgcn_mfma_f32_16x16x32_bf16(af[ks][0], b, acc[tt][0], 0, 0, 0); acc[tt][1] = __builtin_amdgcn_mfma_f32_16x16x32_bf16(af[ks][1], b, acc[tt][1], 0, 0, 0); } }
        f32x4 xin[5][2], g1v[5][2];
#pragma unroll
        for (int tt = 0; tt < 5; ++tt) { const int tok = min(tt * 16 + n16, nr - 1), row = r0 + tok, bidx = row < NL ? (row >> 11) : 8;
#pragma unroll
            for (int nt = 0; nt < 2; ++nt) { const int c = 256 * g + F.wave * 32 + nt * 16 + 4 * kq; xin[tt][nt] = *(const f32x4*)(xrow_ptr(F, row) + c); g1v[tt][nt] = *(const f32x4*)(modv + (bidx * 6 + 2) * 1024 + c); } }
#pragma unroll
        for (int nt = 0; nt < 2; ++nt) { const int c = 256 * g + F.wave * 32 + nt * 16 + 4 * kq; const f32x4 bv = *(const f32x4*)(pb + c), sv = *(const f32x4*)(ps + c);
#pragma unroll
            for (int tt = 0; tt < 5; ++tt) { const int tok = tt * 16 + n16;
                if (tok < nr) { const f32x4 x1 = xin[tt][nt] + (acc[tt][nt] + bv) * sv * g1v[tt][nt];
                    u32x2 w; w.x = pk2(x1.x, x1.y); w.y = pk2(x1.z, x1.w); *(u32x2*)(X1 + (size_t)(r0 + tok) * D + c) = w; } } }
    }
    VM_WAIT(); __syncthreads();
}

constexpr int RW_LD = 1032;
__device__ __forceinline__ void route_phase(Frame& F, const bf16_t* xin, int nrows, int layer, int cl) {
    const int rpb = (nrows + F.G - 1) / F.G, r0 = F.vcu * rpb, r1 = min(nrows, r0 + rpb), nr = r1 > r0 ? r1 - r0 : 0;
    const float* rwt = (const float*)(F.ws + WS_RWT) + (size_t)layer * 32 * 1024;
    LAS bf16_t* rwb = (LAS bf16_t*)F.lds;
    LAS float* lg = (LAS float*)(F.lds + 32 * RW_LD * 2);
    { f32x4 wv[16];
#pragma unroll
      for (int k = 0; k < 16; ++k) wv[k] = ((const f32x4*)rwt)[F.tid + k * NTHR];
#pragma unroll
      for (int k = 0; k < 16; ++k) { const int i = F.tid + k * NTHR, e = i >> 8, c = (i & 255) * 4; u32x2 p; p.x = pk2(wv[k].x, wv[k].y); p.y = pk2(wv[k].z, wv[k].w); *(LAS u32x2*)(rwb + e * RW_LD + c) = p; } }
    LAS int* lcnt = (LAS int*)(F.misc + M_LCNT); LAS int* lbase = (LAS int*)(F.misc + M_LBASE);
    if (F.tid < 32) lcnt[F.tid] = 0;
    const float* ng = F.in[7] + layer * 1024; const float* rb = F.in[19] + layer * 32;
    const float* modv = (const float*)(F.ws + WS_MODV) + (size_t)layer * 9 * 6144;
    unsigned char* H8 = F.ws + WS_H8;
    LAS bf16_t* ht = (LAS bf16_t*)(F.lds + 32 * RW_LD * 2 + 80 * 33 * 4);
    const int lane = F.lane;
    __syncthreads();
    for (int c0r = 0; c0r < nr; c0r += 32) {
        const int cend = min(c0r + 32, nr);
        for (int rl = c0r + F.wave; rl < cend; rl += 2 * NWAVES) {
            const int rlb = rl + NWAVES; const bool hasb = rlb < cend; const int row = r0 + rl, rowb = r0 + rlb, rb_ = hasb ? rowb : row;
            const u32x2* xa = (const u32x2*)(xin + (size_t)row * D) + lane; const u32x2* xb = (const u32x2*)(xin + (size_t)rb_ * D) + lane;
            f32x4 va[4], vb[4]; float sa = 0.f, sb = 0.f;
#pragma unroll
            for (int j = 0; j < 4; ++j) { const u32x2 wa = xa[64 * j], wb = xb[64 * j]; va[j] = (f32x4){bf_lo(wa.x), bf_hi(wa.x), bf_lo(wa.y), bf_hi(wa.y)}; vb[j] = (f32x4){bf_lo(wb.x), bf_hi(wb.x), bf_lo(wb.y), bf_hi(wb.y)}; }
#pragma unroll
            for (int j = 0; j < 4; ++j) { sa += (va[j].x * va[j].x + va[j].y * va[j].y) + (va[j].z * va[j].z + va[j].w * va[j].w); sb += (vb[j].x * vb[j].x + vb[j].y * vb[j].y) + (vb[j].z * vb[j].z + vb[j].w * vb[j].w); }
            const float ra = 1.0f / sqrtf(wave_sum(sa) * (1.0f / D) + EPS), rbv = 1.0f / sqrtf(wave_sum(sb) * (1.0f / D) + EPS);
            const int bia = row < NL ? (row >> 11) : 8, bib = rb_ < NL ? (rb_ >> 11) : 8;
#pragma unroll
            for (int j = 0; j < 4; ++j) { const int col = 256 * j + 4 * lane; const f32x4 g = *(const f32x4*)(ng + col);
                const f32x4 ha = va[j] * ra * g * (*(const f32x4*)(modv + (bia * 6 + 4) * 1024 + col) + 1.0f) + *(const f32x4*)(modv + (bia * 6 + 3) * 1024 + col);
                *(unsigned*)(H8 + (size_t)row * D + col) = pk_fp8x4(ha * 8.0f);
                u32x2 w; w.x = pk2(ha.x, ha.y); w.y = pk2(ha.z, ha.w); *(LAS u32x2*)(ht + (rl - c0r) * RW_LD + col) = w;
                if (hasb) { const f32x4 hb = vb[j] * rbv * g * (*(const f32x4*)(modv + (bib * 6 + 4) * 1024 + col) + 1.0f) + *(const f32x4*)(modv + (bib * 6 + 3) * 1024 + col);
                    *(unsigned*)(H8 + (size_t)rowb * D + col) = pk_fp8x4(hb * 8.0f);
                    u32x2 w2; w2.x = pk2(hb.x, hb.y); w2.y = pk2(hb.z, hb.w); *(LAS u32x2*)(ht + (rlb - c0r) * RW_LD + col) = w2; } }
        }
        __syncthreads();
        if (F.wave < 2 && c0r + F.wave * 16 < nr) {
            const int n = lane & 15, kq = lane >> 4;
            const LAS bf16_t* hp = ht + (F.wave * 16 + n) * RW_LD + kq * 8; const LAS bf16_t* wp = rwb + n * RW_LD + kq * 8;
            f32x4 c0 = (f32x4){0.f, 0.f, 0.f, 0.f}, c1 = c0;
#pragma unroll 8
            for (int ks = 0; ks < 32; ++ks) { const bf16x8 b = *(const LAS bf16x8*)(hp + ks * 32);
                const bf16x8 a0 = *(const LAS bf16x8*)(wp + ks * 32), a1 = *(const LAS bf16x8*)(wp + 16 * RW_LD + ks * 32);
                c0 = __builtin_amdgcn_mfma_f32_16x16x32_bf16(a0, b, c0, 0, 0, 0); c1 = __builtin_amdgcn_mfma_f32_16x16x32_bf16(a1, b, c1, 0, 0, 0); }
            LAS float* lr = lg + (c0r + F.wave * 16 + n) * 33 + 4 * kq;
#pragma unroll
            for (int j = 0; j < 4; ++j) { lr[j] = c0[j] + rb[4 * kq + j]; lr[16 + j] = c1[j] + rb[16 + 4 * kq + j]; }
        }
        __syncthreads();
    }
    int te[4] = {0, 0, 0, 0}, lp[4] = {0, 0, 0, 0}; float tg[4] = {0.f, 0.f, 0.f, 0.f};
    if (F.tid < nr) { const LAS float* l = lg + F.tid * 33; float tv[4] = {-3.0e38f, -3.0e38f, -3.0e38f, -3.0e38f};
#pragma unroll 4
        for (int e = 0; e < 32; ++e) { const float v = l[e];
            if (v > tv[3]) { if (v > tv[0]) { tv[3] = tv[2]; te[3] = te[2]; tv[2] = tv[1]; te[2] = te[1]; tv[1] = tv[0]; te[1] = te[0]; tv[0] = v; te[0] = e; }
                else if (v > tv[1]) { tv[3] = tv[2]; te[3] = te[2]; tv[2] = tv[1]; te[2] = te[1]; tv[1] = v; te[1] = e; }
                else if (v > tv[2]) { tv[3] = tv[2]; te[3] = te[2]; tv[2] = v; te[2] = e; }
                else { tv[3] = v; te[3] = e; } } }
        const float e1 = expf(tv[1] - tv[0]), e2 = expf(tv[2] - tv[0]), e3 = expf(tv[3] - tv[0]), inv = 1.0f / (1.0f + e1 + e2 + e3);
        tg[0] = inv; tg[1] = e1 * inv; tg[2] = e2 * inv; tg[3] = e3 * inv;
#pragma unroll
        for (int k = 0; k < 4; ++k) lp[k] = __hip_atomic_fetch_add(lcnt + te[k], 1, __ATOMIC_RELAXED, __HIP_MEMORY_SCOPE_WORKGROUP); }
    __syncthreads();
    if (F.tid < 32) { const int c = lcnt[F.tid]; lbase[F.tid] = c ? (int)__hip_atomic_fetch_add(F.ctl + CW_GCOUNT + (cl * 32 + F.tid) * 64, (unsigned)c, __ATOMIC_RELAXED, __HIP_MEMORY_SCOPE_AGENT) : 0; }
    __syncthreads();
    if (F.tid < nr) { const int row = r0 + F.tid; float* gate = (float*)(F.ws + WS_ROUTE + (size_t)NT * 16); int* slot_aid = (int*)(F.ws + WS_SLOTAID + (cl >= 2 ? 8 * MiB : 0)); int* slot_tok = (int*)(F.ws + WS_SLOTTOK + (cl >= 2 ? 8 * MiB : 0));
        gst16(gate + (size_t)row * 4, (f32x4)((f32x4){tg[0], tg[1], tg[2], tg[3]}));
#pragma unroll
        for (int k = 0; k < 4; ++k) { const size_t p = (size_t)te[k] * NT + lbase[te[k]] + lp[k]; slot_aid[p] = row * 4 + k; slot_tok[p] = row; } }
    __syncthreads();
}

__device__ __forceinline__ int moe_build(Frame& F, int layer, int ntn, bool gather, const float* bias_g) {
    LAS int* tstart = (LAS int*)(F.misc + M_TSTART); LAS int* gcnt = (LAS int*)(F.misc + M_GCNT); LAS int* tab = (LAS int*)(F.misc + M_TAB);
    __syncthreads();
    if (F.tid < 32) gcnt[F.tid] = (int)F.ctl[CW_GCOUNT + (layer * 32 + F.tid) * 64];
    __syncthreads();
    if (F.tid == 0) { int t = 0; for (int e = 0; e < 32; ++e) { tstart[e] = t; t += (gcnt[e] + 255) >> 8; } tstart[32] = t;
        const int U = t * ntn; int n = 0;
        for (int i = 0; i < 16; ++i) { const int L = i * F.G + (int)blockIdx.x; if (L >= U) break; const int wgid = pg8::xcd_remap(L, U);
            int e = 0; while (tstart[e + 1] * ntn <= wgid) ++e;
            const int loc = wgid - tstart[e] * ntn, mt = loc / ntn; const int nv = gcnt[e] - mt * 256;
            tab[8 * n] = tstart[e] + mt; tab[8 * n + 1] = loc % ntn; tab[8 * n + 2] = e; tab[8 * n + 3] = mt; tab[8 * n + 4] = nv < 256 ? nv : 256; ++n; }
        tab[8 * 16] = n; }
    __syncthreads();
    const int n = tab[8 * 16];
    LAS int* rowl = (LAS int*)(F.lds + TOK_OFF); LAS float* biasl = (LAS float*)(F.lds + BIAS_OFF);
    const int* src = (const int*)(F.ws + (gather ? WS_SLOTTOK : WS_SLOTAID));
    for (int i = F.tid; i < n * 256; i += NTHR) { const int u = i >> 8, r = i & 255, e = tab[8 * u + 2], mt = tab[8 * u + 3], nv = tab[8 * u + 4], pn = tab[8 * u + 1];
        rowl[i] = r < nv ? src[(size_t)e * NT + mt * 256 + r] : (gather ? 0 : -1);
        biasl[i] = gather ? bias_g[(size_t)e * 2048 + (r >> 7) * 1024 + pn * 128 + (r & 127)] : bias_g[(size_t)e * 1024 + pn * 256 + r]; }
    __syncthreads();
    return n;
}

struct CombRow { f32x4 x[4]; u32x2 y[4][2]; f32x4 gt; };
__device__ __forceinline__ void comb_load(CombRow& r, const bf16_t* xi, const unsigned char* YS, const float* gate, int row, int lane) {
    const bf16_t* xp = xi + (size_t)row * D + 8 * lane;
    unpk8(*(const u32x4*)(xp), r.x[0], r.x[1]); unpk8(*(const u32x4*)(xp + 512), r.x[2], r.x[3]);
    r.gt = *(const f32x4*)(gate + (size_t)row * 4);
#pragma unroll
    for (int k = 0; k < 4; ++k) { const unsigned char* yp = YS + ((size_t)row * 4 + k) * D + 8 * lane; r.y[k][0] = *(const u32x2*)(yp); r.y[k][1] = *(const u32x2*)(yp + 512); }
}
template <int MODE> __device__ __forceinline__ void comb_finish(Frame& F, CombRow& r, void* xo_, int row, int layer, int lane) {
    const float* modv = (const float*)(F.ws + WS_MODV); bf16_t* H = (bf16_t*)(F.ws + WS_H);
    const int bidx = row < NL ? (row >> 11) : 8;
    const float* g2 = modv + ((size_t)layer * 9 + bidx) * 6144 + 5 * 1024;
    float ss = 0.f;
#pragma unroll
    for (int hh = 0; hh < 2; ++hh) { f32x4 y0 = (f32x4){0.f, 0.f, 0.f, 0.f}, y1 = y0;
#pragma unroll
        for (int k = 0; k < 4; ++k) { const u32x2 w = r.y[k][hh]; const float gk = r.gt[k] * (1.0f / 16.0f);
            const f32x2 a = __builtin_amdgcn_cvt_pk_f32_fp8((int)w.x, false), b = __builtin_amdgcn_cvt_pk_f32_fp8((int)w.x, true);
            const f32x2 c = __builtin_amdgcn_cvt_pk_f32_fp8((int)w.y, false), d = __builtin_amdgcn_cvt_pk_f32_fp8((int)w.y, true);
            y0.x += gk * a.x; y0.y += gk * a.y; y0.z += gk * b.x; y0.w += gk * b.y;
            y1.x += gk * c.x; y1.y += gk * c.y; y1.z += gk * d.x; y1.w += gk * d.y; }
        const int col = 512 * hh + 8 * lane;
        r.x[2 * hh] = r.x[2 * hh] + *(const f32x4*)(g2 + col) * y0; r.x[2 * hh + 1] = r.x[2 * hh + 1] + *(const f32x4*)(g2 + col + 4) * y1; }
#pragma unroll
    for (int i = 0; i < 4; ++i) ss += (r.x[i].x * r.x[i].x + r.x[i].y * r.x[i].y) + (r.x[i].z * r.x[i].z + r.x[i].w * r.x[i].w);
    const float rinv = 1.0f / sqrtf(wave_sum(ss) * (1.0f / D) + EPS);
    if (MODE == 0) {
        const float* ng = F.in[6] + 1024; const float* sh1 = modv + ((size_t)9 + bidx) * 6144; const float* s1 = sh1 + 1024;
#pragma unroll
        for (int hh = 0; hh < 2; ++hh) { const int col = 512 * hh + 8 * lane;
            *(u32x4*)((bf16_t*)xo_ + (size_t)row * D + col) = pk8(r.x[2 * hh], r.x[2 * hh + 1]);
            const f32x4 h0 = r.x[2 * hh] * rinv * *(const f32x4*)(ng + col) * (*(const f32x4*)(s1 + col) + 1.0f) + *(const f32x4*)(sh1 + col);
            const f32x4 h1 = r.x[2 * hh + 1] * rinv * *(const f32x4*)(ng + col + 4) * (*(const f32x4*)(s1 + col + 4) + 1.0f) + *(const f32x4*)(sh1 + col + 4);
            *(u32x2*)(F.ws + WS_H8 + (size_t)row * D + col) = pk_fp8x8(h0, h1, 8.0f); }
    } else {
        const float* fg = F.in[24];
#pragma unroll
        for (int hh = 0; hh < 2; ++hh) { const int col = 512 * hh + 8 * lane; float* xop = (float*)xo_ + (size_t)row * D + col;
            gst16(xop, (f32x4)(r.x[2 * hh] * rinv * *(const f32x4*)(fg + col))); gst16(xop + 4, (f32x4)(r.x[2 * hh + 1] * rinv * *(const f32x4*)(fg + col + 4))); }
    }
}
template <int MODE> __device__ __forceinline__ void combine_phase(Frame& F, const bf16_t* xi, void* xo, int nrows, int layer) {
    const int rpb = (nrows + F.G - 1) / F.G, r0 = F.vcu * rpb, r1 = min(nrows, r0 + rpb);
    const float* gate = (const float*)(F.ws + WS_ROUTE + (size_t)NT * 16); const unsigned char* YS = F.ws + WS_YS;
    const int lane = F.lane;
    for (int row = r0 + F.wave; row < r1; row += 2 * NWAVES) {
        const int rowb = row + NWAVES; const bool hasb = rowb < r1;
        CombRow ra, rb; comb_load(ra, xi, YS, gate, row, lane); comb_load(rb, xi, YS, gate, hasb ? rowb : row, lane);
        comb_finish<MODE>(F, ra, xo, row, layer, lane);
        if (hasb) comb_finish<MODE>(F, rb, xo, rowb, layer, lane);
    }
}

__device__ __forceinline__ int proj2_build(Frame& F) {
    LAS int* tab = (LAS int*)(F.misc + M_TAB);
    __syncthreads();
    if (F.tid == 0) { const int c = (int)blockIdx.x; int n = 0;
        const unsigned long long aK = (unsigned long long)(F.ws + WS_H8), aQ = (unsigned long long)(F.ws + WS_QA), aV = (unsigned long long)(F.ws + WS_CKV);
        const unsigned long long bK = (unsigned long long)(F.ws + WS_WP1) + (unsigned long long)768 * 1024, bQ = (unsigned long long)(F.ws + WS_WUQ), bV = (unsigned long long)(F.ws + WS_WUKV);
#define P2_PUT(ty_, pm_, pn_, nt_, ab_, bb_) do { const unsigned long long tile_ = (unsigned long long)256 * 128 * (nt_); const unsigned long long pa_ = (ab_) + (pm_) * tile_, pb_ = (bb_) + (pn_) * tile_; \
        tab[8 * n] = (pm_); tab[8 * n + 1] = (pn_); tab[8 * n + 2] = (ty_); tab[8 * n + 3] = (nt_); tab[8 * n + 4] = (int)(unsigned)pa_; tab[8 * n + 5] = (int)(unsigned)(pa_ >> 32); \
        tab[8 * n + 6] = (int)(unsigned)pb_; tab[8 * n + 7] = (int)(unsigned)(pb_ >> 32); ++n; } while (0)
#define P2_KPE(i_) P2_PUT(0, (i_), 0, 8, aK, bK)
#define P2_UQ(i_)  P2_PUT(1, (i_) / 6, (i_) % 6, 4, aQ, bQ)
#define P2_UKV(i_) P2_PUT(2, (i_) / 8, (i_) % 8, 2, aV, bV)
        if (c < 16) { P2_KPE(c); P2_UQ(368 + c); }
        else if (c < 72) { P2_KPE(c); P2_UKV(2 * (c - 16)); P2_UKV(2 * (c - 16) + 1); }
        else { P2_UQ(2 * (c - 72)); P2_UQ(2 * (c - 72) + 1); P2_UKV(112 + 2 * (c - 72)); P2_UKV(112 + 2 * (c - 72) + 1); }
        if (c >= 16 && c < 112) P2_UKV(480 + c - 16);
#undef P2_KPE
#undef P2_PUT
#undef P2_UQ
#undef P2_UKV
        tab[8 * 16] = n; }
    __syncthreads();
    const int n = tab[8 * 16];
    { LAS float* rinvl = (LAS float*)(F.lds + TOK_OFF); const float* ssq = (const float*)(F.ws + WS_SSQ);
      for (int i = F.tid; i < n * 256; i += NTHR) { const int u = i >> 8, r = i & 255, row = tab[8 * u] * 256 + r, ty = tab[8 * u + 2]; float sm = 0.f;
          if (ty == 1) {
#pragma unroll
              for (int p = 0; p < 8; ++p) sm += ssq[(size_t)p * NT + row];
              rinvl[i] = (1.0f / 512.0f) / sqrtf(sm * (1.0f / QLORA) + EPS); }
          else {
#pragma unroll
              for (int p = 8; p < 12; ++p) sm += ssq[(size_t)p * NT + row];
              rinvl[i] = (1.0f / 512.0f) / sqrtf(sm * (1.0f / KVLORA) + EPS); } }
      __syncthreads(); }
    return n;
}

constexpr int NPHASE = 15;
__global__ void __launch_bounds__(NTHR, 2) trunk_fwd(Args args) {
    extern __shared__ __attribute__((aligned(16))) unsigned char lds_raw[];
    Frame F;
    F.lds = (LAS unsigned char*)lds_raw; F.misc = F.lds + MISC_OFF;
    F.tid = threadIdx.x; F.lane = F.tid & 63; F.wave = __builtin_amdgcn_readfirstlane(F.tid >> 6);
    F.G = gridDim.x; { const int bx = blockIdx.x; F.vcu = (F.G % 8 == 0) ? (bx % 8) * (F.G / 8) + bx / 8 : bx; }
    F.ws = args.ws; F.ctl = (unsigned*)(args.ws + WS_CTL); F.out = args.out;
#pragma unroll
    for (int i = 0; i < 25; ++i) F.in[i] = args.in[i];
    if (F.tid < 4) ((LAS unsigned*)(F.misc + M_BAR))[F.tid] = 0u;
    __syncthreads();
    XcdBarrier bar; bar.bar = F.ctl + CW_BAR; bar.x = 0; bar.st = nullptr;
#if !MK_PER_PHASE
    bar = xcd_barrier_post(F.ctl + CW_BAR, (volatile LAS unsigned*)(F.misc + M_BAR));
#endif
    const int lo = args.ph_lo, hi = args.ph_hi;
#ifndef PH_MASK
#define PH_MASK 0xFFFFFFFFu
#endif
#define IN(k) (((PH_MASK >> (k)) & 1u) && lo <= (k) && (k) < hi && ((F.lane = opq(lane_id())), (F.tid = F.wave * 64 + F.lane), true))
#if MK_PER_PHASE
#define SEAM(k) do { } while (0)
#else
#ifndef PROBE_XBAR
#define PROBE_XBAR 0
#endif
#define SEAM(k) do { if (IN((k) + 1)) { for (int xb_ = 0; xb_ <= PROBE_XBAR; ++xb_) xcd_barrier(bar, F.wave == 0 && lane_id() == 0); } } while (0)
#endif
    bf16_t* X1 = (bf16_t*)(F.ws + WS_X1); bf16_t* X2 = (bf16_t*)(F.ws + WS_X2); bf16_t* X3 = (bf16_t*)(F.ws + WS_X3);
    const float* modv = (const float*)(F.ws + WS_MODV);
    const f32x2* rope = (const f32x2*)(F.ws + WS_ROPE);
    float* ssq = (float*)(F.ws + WS_SSQ);
    bf16_t* Hb = (bf16_t*)(F.ws + WS_H);

    if (IN(0)) { REPEAT(0) { p0_prologue(F); } SEAM(0); }
    if (IN(1)) { const int cslot = F.vcu % 3;
        const int cbi = F.vcu / 3, cnb = (F.G - cslot + 2) / 3, cj0 = cslot == 0 ? 0 : (cslot == 1 ? 5464 : 10928), cj1 = cslot == 0 ? 5464 : (cslot == 1 ? 10928 : I_GU8L);
        if (cslot == 0) { REPEAT(16) { convert_experts(F, 0, cj0, cj1, cbi, cnb); __syncthreads(); } }
        pool_block(F, X1);
        if (cslot == 1) { REPEAT(16) { convert_experts(F, 0, cj0, cj1, cbi, cnb); __syncthreads(); } }
        REPEAT(2) { route_phase(F, X1, NT, 0, (rep_ == (int)((REP_MASK >> 2) & 1u)) ? 0 : 2); }
        if (cslot == 2) { REPEAT(16) { __syncthreads(); convert_experts(F, 0, cj0, cj1, cbi, cnb); } }
        SEAM(3); }
    if (IN(4)) {
        REPEAT(4) {
        const bool conv_first = (F.vcu & 1) == 0;
        if (conv_first && rep_ == 0) { convert_experts(F, 0, I_GU8L, I_GU8L + I_DN8L / 2, F.vcu >> 1, F.G / 2); }
        const int n = moe_build(F, 0, 8, true, F.in[21]);
        pg8::MoeSched S{(const LAS int*)(F.misc + M_TAB), n, (const char*)(F.ws + WS_H8), (const char*)(F.ws + WS_WGU), (size_t)0, (size_t)2048 * 1024, (size_t)256 * 1024};
        EpiGu E{F.ws + WS_ACT, (const LAS float*)(F.lds + BIAS_OFF)};
        pg8::gemm_phase<true, true, false>(F.lds, pg8::GemmP{1024, 1024, 8}, S, E, F.wave, PROBE_NOEPI && rep_ > 0);
        if (!conv_first && rep_ == 0) { __syncthreads(); convert_experts(F, 0, I_GU8L + I_DN8L / 2, I_GU8L + I_DN8L, F.vcu >> 1, F.G / 2); }
        }
        SEAM(4);
    }
    if (IN(5)) {
        REPEAT(5) {
        const int n = moe_build(F, 0, 4, false, F.in[23]);
        pg8::MoeSched S{(const LAS int*)(F.misc + M_TAB), n, (const char*)(F.ws + WS_ACT), (const char*)(F.ws + WS_WDN), (size_t)256 * 1024, (size_t)1024 * 1024, (size_t)256 * 1024};
        EpiDown E{F.ws + WS_YS, (const LAS float*)(F.lds + BIAS_OFF), (const LAS int*)(F.lds + TOK_OFF)};
        pg8::gemm_phase<true, false, false>(F.lds, pg8::GemmP{1024, 1024, 8}, S, E, F.wave, PROBE_NOEPI && rep_ > 0);
        }
        SEAM(5);
    }
    if (IN(6)) { REPEAT(6) { combine_phase<0>(F, X1, X2, NT, 0); } SEAM(6); }
    if (IN(7)) {
        REPEAT(7) {
        pg8::PlainSched S{NT / 256, 3, (NT / 256) * 3, F.G, (int)blockIdx.x, (const char*)(F.ws + WS_H8), (const char*)(F.ws + WS_WP1), (size_t)256 * 1024, 0, (size_t)256 * 1024};
        EpiP1 E{F.ws + WS_QA, F.ws + WS_CKV, ssq};
        pg8::gemm_phase<true, false, false>(F.lds, pg8::GemmP{1024, 1024, 8}, S, E, F.wave, PROBE_NOEPI && rep_ > 0);
        }
        SEAM(7);
    }
    if (IN(8)) {
        REPEAT(8) {
        const int n = proj2_build(F);
        Proj2Sched S{(const LAS int*)(F.misc + M_TAB), n};
        EpiProj2 E{EpiKpe{F.ws + WS_K, rope}, EpiUq{F.ws + WS_Q, (const LAS float*)(F.lds + TOK_OFF), rope}, EpiUkv{F.ws + WS_K, (bf16_t*)(F.ws + WS_V), (const LAS float*)(F.lds + TOK_OFF)}};
        pg8::gemm_phase<true, false, true>(F.lds, pg8::GemmP{0, 0, 0}, S, E, F.wave, PROBE_NOEPI && rep_ > 0);
        }
        SEAM(8);
    }
    if (IN(9)) {
        REPEAT(9) {
        const unsigned char* Q = F.ws + WS_Q; const unsigned char* K = F.ws + WS_K; const bf16_t* V = (const bf16_t*)(F.ws + WS_V); unsigned char* O = F.ws + WS_ATT;
        const int cslot = (F.vcu + 1) % 3;
        const int c9nb = (F.G - (F.vcu % 3) + 2) / 3, c9j0 = cslot * 8192, c9j1 = cslot * 8192 + 8192;
        int k = 0;
        for (int u = F.vcu; u < NB * NH * (SEQ / 256); u += F.G, ++k) { const int qb = u & 7, bh = u >> 3, b = bh >> 3, h = bh & 7;
            __syncthreads();
            if (k == cslot && rep_ == 0) { convert_experts(F, 1, c9j0, c9j1, F.vcu / 3, c9nb); __syncthreads(); }
            att::attn_unit<0>(Q + ((size_t)bh * SEQ + qb * 256) * DQK, K + (size_t)bh * SKV * DQK, V + (size_t)bh * SKV * DV, O + ((size_t)b * SEQ + qb * 256) * 1024 + h * 128, F.lds, F.wave); }
        if (cslot == 2 && rep_ == 0) { __syncthreads(); convert_experts(F, 1, c9j0, c9j1, F.vcu / 3, c9nb); }
        }
        SEAM(9);
    }
    if (IN(10)) {
        REPEAT(10) {
        pg8::PlainSched S{NL / 256, 4, (NL / 256) * 4, F.G, (int)blockIdx.x, (const char*)(F.ws + WS_ATT), (const char*)(F.ws + WS_WO), (size_t)256 * 1024, 0, (size_t)256 * 1024};
        EpiWo E{X2, X3, modv + 9 * 6144};
        pg8::gemm_phase<true, false, false>(F.lds, pg8::GemmP{1024, 1024, 8}, S, E, F.wave, PROBE_NOEPI && rep_ > 0);
        }
        SEAM(10);
    }
    if (PROBE_ATT != 0 && IN(11)) {
        const unsigned char* Q = F.ws + WS_Q; const unsigned char* K = F.ws + WS_K; const bf16_t* V = (const bf16_t*)(F.ws + WS_V); unsigned char* O = F.ws + WS_ATT;
        for (int u = F.vcu; u < NB * NH * (SEQ / 256); u += F.G) { const int qb = u & 7, bh = u >> 3, b = bh >> 3, h = bh & 7;
            __syncthreads();
            att::attn_unit<PROBE_ATT>(Q + ((size_t)bh * SEQ + qb * 256) * DQK, K + (size_t)bh * SKV * DQK, V + (size_t)bh * SKV * DV, O + ((size_t)b * SEQ + qb * 256) * 1024 + h * 128, F.lds, F.wave); }
        __syncthreads(); }
    if (IN(11)) { REPEAT(11) { route_phase(F, X3, NL, 1, (rep_ == (int)((REP_MASK >> 11) & 1u)) ? 1 : 3); } SEAM(11); }
    if (IN(12)) {
        REPEAT(12) {
        const int n = moe_build(F, 1, 8, true, F.in[21] + 32 * 2048);
        pg8::MoeSched S{(const LAS int*)(F.misc + M_TAB), n, (const char*)(F.ws + WS_H8), (const char*)(F.ws + WS_WGU) + (size_t)32 * 2048 * 1024, (size_t)0, (size_t)2048 * 1024, (size_t)256 * 1024};
        EpiGu E{F.ws + WS_ACT, (const LAS float*)(F.lds + BIAS_OFF)};
        pg8::gemm_phase<true, true, false>(F.lds, pg8::GemmP{1024, 1024, 8}, S, E, F.wave, PROBE_NOEPI && rep_ > 0);
        }
        SEAM(12);
    }
    if (IN(13)) {
        REPEAT(13) {
        const int n = moe_build(F, 1, 4, false, F.in[23] + 32 * 1024);
        pg8::MoeSched S{(const LAS int*)(F.misc + M_TAB), n, (const char*)(F.ws + WS_ACT), (const char*)(F.ws + WS_WDN) + (size_t)32 * 1024 * 1024, (size_t)256 * 1024, (size_t)1024 * 1024, (size_t)256 * 1024};
        EpiDown E{F.ws + WS_YS, (const LAS float*)(F.lds + BIAS_OFF), (const LAS int*)(F.lds + TOK_OFF)};
        pg8::gemm_phase<true, false, false>(F.lds, pg8::GemmP{1024, 1024, 8}, S, E, F.wave, PROBE_NOEPI && rep_ > 0);
        }
        SEAM(13);
    }
    if (IN(14)) { REPEAT(14) { combine_phase<1>(F, X3, F.out, NL, 1); } }
#undef IN
#undef SEAM
}

extern "C" void kernel_launch(void* const* d_in, const int* in_sizes, int n_in, void* d_out, int out_size, void* d_ws, size_t ws_size, hipStream_t stream) {
    static int ready = 0;
    if (ready == 0) {
        if (n_in != 25 || out_size != NL * D || ws_size < WS_END) { fprintf(stderr, "kernel_launch: unexpected shapes: n_in %d out %d ws %zu (need >= %zu)\n", n_in, out_size, ws_size, (size_t)WS_END); ready = -1; return; }
        if (hipFuncSetAttribute((const void*)trunk_fwd, hipFuncAttributeMaxDynamicSharedMemorySize, LDS_BYTES) != hipSuccess) { fprintf(stderr, "kernel_launch: hipFuncSetAttribute failed\n"); ready = -1; return; }
        int per_cu = 0;
        if (hipOccupancyMaxActiveBlocksPerMultiprocessor(&per_cu, (const void*)trunk_fwd, NTHR, LDS_BYTES) != hipSuccess || per_cu < 1)
            fprintf(stderr, "kernel_launch: note: occupancy query reports %d workgroups per CU\n", per_cu);
        (void)hipGetLastError();
        ready = 1;
    }
    if (ready < 0) return;
    (void)hipMemsetAsync((char*)d_ws + WS_CTL, 0, CTL_ZERO_BYTES, stream);
    Args a{};
    for (int i = 0; i < 25; ++i) a.in[i] = (const float*)d_in[i];
    a.out = (float*)d_out; a.ws = (unsigned char*)d_ws;
#if MK_PER_PHASE
    for (int p = 0; p < NPHASE; ++p) { a.ph_lo = p; a.ph_hi = p + 1; hipLaunchKernelGGL(trunk_fwd, dim3(GRID), dim3(NTHR), LDS_BYTES, stream, a); }
#else
    a.ph_lo = 0; a.ph_hi = NPHASE; hipLaunchKernelGGL(trunk_fwd, dim3(GRID), dim3(NTHR), LDS_BYTES, stream, a);
#endif
    const hipError_t le = hipPeekAtLastError();
    if (le != hipSuccess) fprintf(stderr, "kernel_launch: launch failed: %s\n", hipGetErrorName(le));
}
```

```cpp
#include <hip/hip_runtime.h>
#include <cstdio>
#include <cstdint>

#ifndef MK_PER_PHASE
#define MK_PER_PHASE 0
#endif

#ifndef REP_MASK
#define REP_MASK 0u
#endif
#ifndef PROBE_ATT
#define PROBE_ATT 0
#endif
#ifndef PROBE_NOEPI
#define PROBE_NOEPI 0
#endif
__device__ __forceinline__ int rep_bound(int v) { if (REP_MASK != 0u) asm volatile("" : "+s"(v)); return v; }
#define REPEAT(k) _Pragma("nounroll") for (int rep_ = 0, repn_ = rep_bound((int)((REP_MASK >> (k)) & 1u)); rep_ <= repn_; ++rep_) if (rep_ > 0 ? (__syncthreads(), true) : true)
#define LAS __attribute__((address_space(3)))
typedef unsigned short bf16_t;
typedef short bf16x8 __attribute__((ext_vector_type(8)));
typedef short s16x4 __attribute__((ext_vector_type(4)));
typedef float f32x4 __attribute__((ext_vector_type(4)));
typedef float f32x2 __attribute__((ext_vector_type(2)));
typedef float f32x16 __attribute__((ext_vector_type(16)));
typedef unsigned u32x4 __attribute__((ext_vector_type(4)));
typedef unsigned u32x2 __attribute__((ext_vector_type(2)));

constexpr int D = 1024, NB = 8, SEQ = 2048, CTXL = 256;
constexpr int NL = NB * SEQ, NC = NB * CTXL, NT = NL + NC;
constexpr int NE = 32, TOPK = 4;
constexpr int NH = 8, QLORA = 512, KVLORA = 256, DNOPE = 128, DROPE = 64, DV = 128, DQK = 192, SKV = CTXL + SEQ;
constexpr float EPS = 1e-6f;
constexpr int MAXSLOT0 = NT * TOPK + NE * 256;
constexpr int NWAVES = 8, NTHR = 512, GRID = 256;

constexpr size_t MiB = 1u << 20;
constexpr size_t WS_CTL = 0, CTL_ZERO_BYTES = 64 * 1024;
constexpr size_t WS_MODV = 1 * MiB;
constexpr size_t WS_ROPE = WS_MODV + 512 * 1024;
constexpr size_t WS_RWT = WS_ROPE + 64 * 1024;
constexpr size_t WS_SSQ = 2 * MiB;
constexpr size_t WS_ROUTE = 3 * MiB;
constexpr size_t WS_BLKCNT = WS_ROUTE + 3 * (size_t)NT * 4 * 4;
constexpr size_t WS_SLOTAID = 1326 * MiB;
constexpr size_t WS_SLOTTOK = 1330 * MiB;
constexpr size_t WS_WPOOL = 5 * MiB, WS_WP1 = 6 * MiB, WS_WUQ = 8 * MiB, WS_WUKV = 10 * MiB, WS_WO = 12 * MiB;
constexpr size_t WS_WGU = 16 * MiB;
constexpr size_t WS_WDN = 272 * MiB;
constexpr size_t WS_H8 = 1306 * MiB;
constexpr size_t WS_X1 = 400 * MiB, WS_X2 = 472 * MiB, WS_X3 = 544 * MiB;
constexpr size_t WS_H = 608 * MiB;
constexpr size_t WS_XS = 644 * MiB, WS_ACT = 804 * MiB, WS_YS = 964 * MiB;
constexpr size_t WS_QA = 1108 * MiB, WS_CKV = 1126 * MiB, WS_Q = 1136 * MiB, WS_K = 1184 * MiB, WS_V = 1238 * MiB, WS_ATT = 1274 * MiB;
constexpr size_t WS_END = 1334 * MiB;
constexpr int CW_BAR = 1024;
constexpr int CW_GCOUNT = 8192;

constexpr int RING_BYTES = 131072;
constexpr int MISC_OFF = 154624;
constexpr int LDS_BYTES = 163840;
constexpr int M_BAR = 0, M_TAB = 64, M_TSTART = 640, M_GCNT = 896, M_LCNT = 1024, M_LBASE = 1152, M_RINV = 8192;
constexpr int TOK_OFF = 131072;
constexpr int BIAS_OFF = TOK_OFF + 10240;

__device__ __forceinline__ unsigned f2bf(float f) { unsigned u = __builtin_bit_cast(unsigned, f); return (u + 0x7fffu + ((u >> 16) & 1u)) >> 16; }
__device__ __forceinline__ unsigned pk2(float lo, float hi) { return f2bf(lo) | (f2bf(hi) << 16); }
__device__ __forceinline__ unsigned cvt_pk_bf16(float lo, float hi) { unsigned r; asm volatile("v_cvt_pk_bf16_f32 %0, %1, %2" : "=v"(r) : "v"(lo), "v"(hi)); return r; }
__device__ __forceinline__ float bf_lo(unsigned w) { return __builtin_bit_cast(float, w << 16); }
__device__ __forceinline__ float bf_hi(unsigned w) { return __builtin_bit_cast(float, w & 0xffff0000u); }
__device__ __forceinline__ float wave_sum(float v) {
#pragma unroll
    for (int o = 1; o < 64; o <<= 1) v += __shfl_xor(v, o);
    return v;
}
__device__ __forceinline__ int opq(int v) { asm volatile("" : "+v"(v)); return v; }
__device__ __forceinline__ int lane_id() { int v; asm volatile("v_mbcnt_lo_u32_b32 %0, -1, 0\n\tv_mbcnt_hi_u32_b32 %0, -1, %0" : "=v"(v)); return v; }
__device__ __forceinline__ float clamp8(float v) { return fminf(fmaxf(v, -448.f), 448.f); }
__device__ __forceinline__ unsigned pk_fp8x4(f32x4 v) { int p = __builtin_amdgcn_cvt_pk_fp8_f32(clamp8(v.x), clamp8(v.y), 0, false); p = __builtin_amdgcn_cvt_pk_fp8_f32(clamp8(v.z), clamp8(v.w), p, true); return (unsigned)p; }
__device__ __forceinline__ const char* uni_ptr(const char* p) { const unsigned long long x = (unsigned long long)p; const unsigned lo = __builtin_amdgcn_readfirstlane((unsigned)x), hi = __builtin_amdgcn_readfirstlane((unsigned)(x >> 32)); return (const char*)(((unsigned long long)hi << 32) | lo); }
#ifndef WT_STORES
#define WT_STORES 0
#endif
__device__ __forceinline__ void gst16(void* p, u32x4 v) {
#if WT_STORES
    asm volatile("global_store_dwordx4 %0, %1, off sc1" :: "v"(p), "v"(v) : "memory");
#else
    *(u32x4*)p = v;
#endif
}
__device__ __forceinline__ void gst16(void* p, f32x4 v) { gst16(p, __builtin_bit_cast(u32x4, v)); }
__device__ __forceinline__ u32x2 pk_fp8x8(f32x4 a, f32x4 b, float sc) { u32x2 r; r.x = pk_fp8x4(a * sc); r.y = pk_fp8x4(b * sc); return r; }
__device__ __forceinline__ void unpk8(u32x4 w, f32x4& a, f32x4& b) { a = (f32x4){bf_lo(w.x), bf_hi(w.x), bf_lo(w.y), bf_hi(w.y)}; b = (f32x4){bf_lo(w.z), bf_hi(w.z), bf_lo(w.w), bf_hi(w.w)}; }
__device__ __forceinline__ u32x4 pk8(f32x4 a, f32x4 b) { u32x4 w; w.x = pk2(a.x, a.y); w.y = pk2(a.z, a.w); w.z = pk2(b.x, b.y); w.w = pk2(b.z, b.w); return w; }
#define LDS_WAIT() asm volatile("s_waitcnt lgkmcnt(0)" ::: "memory")
#define VM_WAIT() asm volatile("s_waitcnt vmcnt(0)" ::: "memory")

#define XB_TMO      128
#define XB_XCNT(j)  (256  + 64 * (j))
#define XB_XSUB(j)  (1280 + 64 * (j))
#define XB_XGEN(j)  (2304 + 64 * (j))
#define XB_TOP      3328
#define XB_TOPGEN   3392
#define XCD_BAR_WORDS 3456
#define XB_SPIN_CAP (1u << 18)
__device__ __forceinline__ unsigned xb_ld(unsigned* p)              { return __hip_atomic_load(p, __ATOMIC_RELAXED, __HIP_MEMORY_SCOPE_AGENT); }
__device__ __forceinline__ unsigned xb_add(unsigned* p, unsigned v) { return __hip_atomic_fetch_add(p, v, __ATOMIC_RELAXED, __HIP_MEMORY_SCOPE_AGENT); }
__device__ __forceinline__ unsigned xb_xcc_id() { return (unsigned)__builtin_amdgcn_s_getreg((3 << 11) | 20) & 0xFu; }
#define XB_SPIN(cond, bar) do { unsigned _sp = 0; while (cond) { __builtin_amdgcn_s_sleep(1); \
    if ((++_sp & 255u) == 0u) { if (xb_ld(&(bar)[XB_TMO])) break; if (_sp > XB_SPIN_CAP) { atomicAdd(&(bar)[XB_TMO], 1u); break; } } } } while (0)
struct XcdBarrier { unsigned* bar; unsigned x; volatile LAS unsigned* st; };
__device__ __forceinline__ XcdBarrier xcd_barrier_post(unsigned* bar, volatile LAS unsigned* st) {
    XcdBarrier b; b.bar = bar; b.x = xb_xcc_id(); b.st = st;
    if (threadIdx.x == 0) (void)xb_add(&bar[XB_XCNT(b.x)], 1u);
    return b;
}
__device__ __forceinline__ void xcd_barrier_complete(unsigned* bar, unsigned x, unsigned& nloc, unsigned& nx) {
    const unsigned G = gridDim.x * gridDim.y * gridDim.z;
    unsigned sum, cnt, mine, sp = 0u;
    for (;;) {
        sum = 0u; cnt = 0u; mine = 0u;
#pragma unroll
        for (unsigned j = 0; j < 16; ++j) { const unsigned c = xb_ld(&bar[XB_XCNT(j)]); sum += c; cnt += (c > 0u) ? 1u : 0u; mine = (j == x) ? c : mine; }
        if (sum == G) break;
        __builtin_amdgcn_s_sleep(1);
        if ((++sp & 255u) == 0u) { if (xb_ld(&bar[XB_TMO])) break; if (sp > XB_SPIN_CAP) { atomicAdd(&bar[XB_TMO], 1u); break; } }
    }
    nloc = mine > 0u ? mine : 1u; nx = cnt > 0u ? cnt : 1u;
}
__device__ __forceinline__ void xcd_barrier(const XcdBarrier& b, bool leader) {
    asm volatile("s_waitcnt vmcnt(0)" ::: "memory");
    __syncthreads();
    if (leader) {
        unsigned* bar = b.bar;
        __builtin_amdgcn_s_waitcnt(0);
        unsigned nloc = b.st[0], nx = b.st[1];
        if (nloc == 0u) { xcd_barrier_complete(bar, b.x, nloc, nx); b.st[0] = nloc; b.st[1] = nx; }
        const unsigned old = xb_add(&bar[XB_XSUB(b.x)], 1u);
        const unsigned gen = old / nloc;
        if (old + 1u == (gen + 1u) * nloc) {
            __builtin_amdgcn_fence(__ATOMIC_RELEASE, "agent");
            asm volatile("s_waitcnt vmcnt(0)" ::: "memory");
            const unsigned og = xb_add(&bar[XB_TOP], 1u);
            const unsigned tg = og / nx;
            if (og + 1u == (tg + 1u) * nx) xb_add(&bar[XB_TOPGEN], 1u);
            else XB_SPIN(xb_ld(&bar[XB_TOPGEN]) == tg, bar);
            __builtin_amdgcn_fence(__ATOMIC_ACQUIRE, "agent");
            xb_add(&bar[XB_XGEN(b.x)], 1u);
            asm volatile("s_waitcnt vmcnt(0)" ::: "memory");
        } else {
            XB_SPIN(xb_ld(&bar[XB_XGEN(b.x)]) == gen, bar);
            __builtin_amdgcn_fence(__ATOMIC_ACQUIRE, "agent");
            asm volatile("s_waitcnt vmcnt(0)" ::: "memory");
        }
    }
    __syncthreads();
}

namespace pg8 {
constexpr int BM = 256, BK = 64, HALF = 128, HTB = HALF * BK * 2, STAGE_BYTES = 8 * HTB;
__host__ __device__ __forceinline__ int lds_byte(int r, int c) { const int st = (r >> 4) * 2 + (c >> 5), rr = r & 15, cc = c & 31, ob = rr * 64 + cc * 2; return st * 1024 + (ob ^ (((ob >> 9) & 1) << 5)); }
__host__ __device__ __forceinline__ void stage_rc(int b, int& R, int& C) { const int st = b / 1024, sb = b % 1024, swz = sb ^ (((sb >> 9) & 1) << 5); R = (st >> 1) * 16 + swz / 64; C = (st & 1) * 32 + (swz % 64) / 2; }
__host__ __device__ __forceinline__ int perm32(int rho) { const int n = rho >> 4, i = rho & 15; return 8 * (i >> 2) + 4 * n + (i & 3); }

struct Unit { int pm, pn, e, mt, nv, nt; const char* A; const char* B; };
struct GemmP { int ldaB, ldbB, nt; };
typedef int i32x4 __attribute__((ext_vector_type(4)));
typedef int i32x8 __attribute__((ext_vector_type(8)));
typedef float f32x8 __attribute__((ext_vector_type(8)));
__device__ __forceinline__ i32x8 cat8(bf16x8 a, bf16x8 b) { return __builtin_shufflevector(__builtin_bit_cast(i32x4, a), __builtin_bit_cast(i32x4, b), 0, 1, 2, 3, 4, 5, 6, 7); }

__device__ __forceinline__ int xcd_remap(int L, int nwg) { const int q = nwg / 8, r = nwg % 8, xcd = L % 8, off = L / 8; return (xcd < r ? xcd * (q + 1) : r * (q + 1) + (xcd - r) * q) + off; }

struct PlainSched {
    int nM, nN, nwg, G, c; const char* Ab; const char* Bb; size_t a_t, a_n, b_t;
    __device__ __forceinline__ bool next(int i, Unit& u) const {
        const int L = i * G + c; if (L >= nwg) return false;
        const int wgid = xcd_remap(L, nwg);
        const int nig = 8 * nN, gid = wgid / nig, fm = gid * 8, gsz = (nM - fm) < 8 ? (nM - fm) : 8;
        u.pm = fm + ((wgid % nig) % gsz); u.pn = (wgid % nig) / gsz; u.e = 0; u.mt = 0; u.nv = 256; u.nt = 0;
        u.A = Ab + (size_t)u.pm * a_t + (size_t)u.pn * a_n; u.B = Bb + (size_t)u.pn * b_t; return true;
    }
};
struct MoeSched {
    const LAS int* tab; int n; const char* Ab; const char* Bb; size_t a_t, b_e, b_t;
    __device__ __forceinline__ bool next(int i, Unit& u) const {
        if (i >= n) return false;
        u.pm = __builtin_amdgcn_readfirstlane(tab[8 * i]); u.pn = __builtin_amdgcn_readfirstlane(tab[8 * i + 1]); u.e = __builtin_amdgcn_readfirstlane(tab[8 * i + 2]);
        u.mt = __builtin_amdgcn_readfirstlane(tab[8 * i + 3]); u.nv = __builtin_amdgcn_readfirstlane(tab[8 * i + 4]); u.nt = i;
        u.A = Ab + (size_t)u.pm * a_t; u.B = Bb + (size_t)u.e * b_e + (size_t)u.pn * b_t; return true;
    }
};

template <bool FP8, bool GATHER, bool VARK, class Epi, class Sched>
__device__ __forceinline__ void gemm_phase(LAS unsigned char* lds, const GemmP g, const Sched& S, const Epi& E, int wave_s, bool skip_epi = false) {
    const int lane = opq(lane_id()), wid = wave_s, tid = wid * 64 + lane, wr = wid >> 2, wc = wid & 3, fr = lane & 15, fq = lane >> 4;
    int RA, RB, C2; { int R, C; stage_rc(tid * 16, R, C); RA = R; RB = Epi::PERM ? ((R & ~31) + perm32(R & 31)) : R; C2 = C * 2; }
    const LAS int* tokl = (const LAS int*)(lds + TOK_OFF); unsigned gof[2][2] = {{0u, 0u}, {0u, 0u}};
#define PG8_TOKOFF(ui_, h_, q_) ((unsigned)tokl[(ui_) * 256 + (h_) * 128 + (q_) * 64 + RA] * (unsigned)g.ldaB + (unsigned)C2)
    const size_t kstep = (size_t)(BK * 2);
    const unsigned ldsw = (unsigned)wid * 1024u;
    const int aoff = lds_byte(wr * 64 + fr, fq * 8), boff = lds_byte(wc * 32 + fr, fq * 8);
#define PG8_SA(b, h) (((b) * 2 + (h)) * HTB)
#define PG8_SB(b, h) ((4 + (b) * 2 + (h)) * HTB)
#define PG8_STAGE_X(bufoff, gbase, Rrow_, ld_) do { const unsigned vo_ = (unsigned)(Rrow_) * (unsigned)(ld_) + (unsigned)C2; _Pragma("unroll") for (int _i = 0; _i < 2; ++_i) { \
        const char* gb_ = uni_ptr((const char*)(gbase) + (size_t)_i * 64 * (ld_)); asm volatile("" : "+s"(gb_)); \
        __builtin_amdgcn_global_load_lds((const unsigned*)(gb_ + vo_), (LAS unsigned*)(lds + (bufoff) + ldsw + _i * 8192), 16, 0, 0); } } while (0)
#define PG8_STAGE_B(bufoff, bbase, h_, ld_) PG8_STAGE_X(bufoff, (bbase) + (size_t)(h_) * 128 * (ld_), RB, ld_)
#define PG8_STAGE_A(bufoff, abase, h_, ld_) do { if constexpr (GATHER) { _Pragma("unroll") for (int _i = 0; _i < 2; ++_i) { const char* gb_ = (const char*)(abase); asm volatile("" : "+s"(gb_)); \
        __builtin_amdgcn_global_load_lds((const unsigned*)(gb_ + gof[h_][_i]), (LAS unsigned*)(lds + (bufoff) + ldsw + _i * 8192), 16, 0, 0); } } \
        else { PG8_STAGE_X(bufoff, (abase) + (size_t)(h_) * 128 * (ld_), RA, ld_); } } while (0)
#define PG8_LDA(dst, b, h) do { _Pragma("unroll") for (int m = 0; m < 4; ++m) _Pragma("unroll") for (int k = 0; k < 2; ++k) dst[m][k] = *(const LAS bf16x8*)(lds + PG8_SA(b, h) + aoff + m * 2048 + k * 1024); } while (0)
#define PG8_LDB(dst, b, h) do { _Pragma("unroll") for (int n = 0; n < 2; ++n) _Pragma("unroll") for (int k = 0; k < 2; ++k) dst[n][k] = *(const LAS bf16x8*)(lds + PG8_SB(b, h) + boff + n * 2048 + k * 1024); } while (0)
#define PG8_MMA1(ai, bj, m, At, Bt, n, HALF_) do { f32x4 c_ = acc[ai][bj][m].HALF_; \
        if constexpr (FP8) c_ = __builtin_amdgcn_mfma_scale_f32_16x16x128_f8f6f4(cat8(Bt[n][0], Bt[n][1]), cat8(At[m][0], At[m][1]), c_, 0, 0, 0, 0, 0, 0); \
        else { _Pragma("unroll") for (int k = 0; k < 2; ++k) c_ = __builtin_amdgcn_mfma_f32_16x16x32_bf16(Bt[n][k], At[m][k], c_, 0, 0, 0); } \
        acc[ai][bj][m].HALF_ = c_; } while (0)
#define PG8_MMA(ai, bj, At, Bt) do { __builtin_amdgcn_s_setprio(1); _Pragma("unroll") for (int m = 0; m < 4; ++m) { PG8_MMA1(ai, bj, m, At, Bt, 0, lo); PG8_MMA1(ai, bj, m, At, Bt, 1, hi); } \
        __builtin_amdgcn_s_setprio(0); } while (0)
#define PG8_WAIT_V(n) asm volatile("s_waitcnt vmcnt(" #n ")" ::: "memory")
#define PG8_WAIT_L(n) asm volatile("s_waitcnt lgkmcnt(" #n ")" ::: "memory")
#define PG8_BAR __builtin_amdgcn_s_barrier()
#define PG8_SCHED __builtin_amdgcn_sched_barrier(0)
    Unit cur, nxt; int ui = 0;
    if (!S.next(0, cur)) return;
    const char* cA = cur.A; const char* cB = cur.B;
    int ntc = VARK ? cur.nt : g.nt; unsigned ldAc = VARK ? 128u * (unsigned)cur.nt : (unsigned)g.ldaB, ldBc = VARK ? 128u * (unsigned)cur.nt : (unsigned)g.ldbB;
    if constexpr (GATHER) {
#pragma unroll
        for (int h = 0; h < 2; ++h)
#pragma unroll
            for (int q = 0; q < 2; ++q) gof[h][q] = PG8_TOKOFF(0, h, q); }
    PG8_STAGE_B(PG8_SB(0, 0), cB, 0, ldBc); PG8_STAGE_B(PG8_SB(0, 1), cB, 1, ldBc); PG8_STAGE_A(PG8_SA(0, 0), cA, 0, ldAc); PG8_STAGE_A(PG8_SA(0, 1), cA, 1, ldAc);
    if (wr == 1) PG8_BAR;
    PG8_WAIT_V(2); PG8_BAR;
    PG8_STAGE_B(PG8_SB(1, 0), cB + kstep, 0, ldBc); PG8_STAGE_A(PG8_SA(1, 0), cA + kstep, 0, ldAc); PG8_STAGE_B(PG8_SB(1, 1), cB + kstep, 1, ldBc);
    PG8_WAIT_V(6); PG8_BAR;
    f32x8 acc[2][2][4];
#pragma unroll
    for (int a = 0; a < 2; ++a)
#pragma unroll
        for (int b = 0; b < 2; ++b)
#pragma unroll
            for (int m = 0; m < 4; ++m) acc[a][b][m] = (f32x8){0.f, 0.f, 0.f, 0.f, 0.f, 0.f, 0.f, 0.f};
    bf16x8 At[4][2], B0[2][2], B1[2][2];
    for (;;) {
        const bool has_next = S.next(ui + 1, nxt);
        const char* nA = has_next ? nxt.A : cA; const char* nB = has_next ? nxt.B : cB;
        const int ntn = (VARK && has_next) ? nxt.nt : ntc; const unsigned ldAn = (VARK && has_next) ? 128u * (unsigned)nxt.nt : ldAc, ldBn = (VARK && has_next) ? 128u * (unsigned)nxt.nt : ldBc;
#pragma nounroll
        for (int t = 0; t < ntc; t += 2) {
            const bool last = (t == ntc - 2);
            const char* a1 = cA + (size_t)(t + 1) * kstep;
            const char* a2 = last ? nA : cA + (size_t)(t + 2) * kstep; const char* b2 = last ? nB : cB + (size_t)(t + 2) * kstep;
            const char* a3 = a2 + kstep; const char* b3 = b2 + kstep;
            const unsigned ldAx = last ? ldAn : ldAc, ldBx = last ? ldBn : ldBc;
            if constexpr (GATHER) { if (last && has_next) { gof[0][0] = PG8_TOKOFF(ui + 1, 0, 0); gof[0][1] = PG8_TOKOFF(ui + 1, 0, 1); } }
            PG8_LDB(B0, 0, 0); PG8_LDB(B1, 0, 1); PG8_SCHED; PG8_LDA(At, 0, 0); PG8_STAGE_A(PG8_SA(1, 1), a1, 1, ldAc);
            if constexpr (GATHER) { if (last && has_next) { gof[1][0] = PG8_TOKOFF(ui + 1, 1, 0); gof[1][1] = PG8_TOKOFF(ui + 1, 1, 1); } }
            PG8_WAIT_V(8); PG8_WAIT_L(0); PG8_BAR; PG8_MMA(0, 0, At, B0); PG8_MMA(0, 1, At, B1); PG8_BAR; PG8_SCHED;
            PG8_LDA(At, 0, 1); PG8_STAGE_B(PG8_SB(0, 0), b2, 0, ldBx); PG8_STAGE_B(PG8_SB(0, 1), b2, 1, ldBx); PG8_STAGE_A(PG8_SA(0, 0), a2, 0, ldAx);
            PG8_WAIT_V(8); PG8_WAIT_L(0); PG8_BAR; PG8_MMA(1, 0, At, B0); PG8_MMA(1, 1, At, B1); PG8_BAR; PG8_SCHED;
            PG8_LDB(B0, 1, 0); PG8_LDB(B1, 1, 1); PG8_SCHED; PG8_LDA(At, 1, 0); PG8_STAGE_A(PG8_SA(0, 1), a2, 1, ldAx);
            PG8_WAIT_V(8); PG8_WAIT_L(0); PG8_BAR; PG8_MMA(0, 0, At, B0); PG8_MMA(0, 1, At, B1); PG8_BAR; PG8_SCHED;
            PG8_LDA(At, 1, 1); PG8_STAGE_B(PG8_SB(1, 0), b3, 0, ldBx); PG8_STAGE_B(PG8_SB(1, 1), b3, 1, ldBx); PG8_STAGE_A(PG8_SA(1, 0), a3, 0, ldAx);
            PG8_WAIT_V(8); PG8_WAIT_L(0); PG8_BAR; PG8_MMA(1, 0, At, B0); PG8_MMA(1, 1, At, B1); PG8_BAR; PG8_SCHED;
        }
        if (wr == 0) PG8_BAR;
        { const int lane2 = opq(lane_id()); f32x4 accv[2][2][4][2];
#pragma unroll
          for (int a = 0; a < 2; ++a)
#pragma unroll
              for (int b = 0; b < 2; ++b)
#pragma unroll
                  for (int m = 0; m < 4; ++m) { accv[a][b][m][0] = acc[a][b][m].lo; accv[a][b][m][1] = acc[a][b][m].hi; }
          if (!skip_epi) E(accv, cur, wr, wc, lane2 & 15, lane2 >> 4); }
        if (!has_next) break;
#pragma unroll
        for (int a = 0; a < 2; ++a)
#pragma unroll
            for (int b = 0; b < 2; ++b)
#pragma unroll
                for (int m = 0; m < 4; ++m) acc[a][b][m] = (f32x8){0.f, 0.f, 0.f, 0.f, 0.f, 0.f, 0.f, 0.f};
        cur = nxt; cA = nA; cB = nB; ntc = ntn; ldAc = ldAn; ldBc = ldBn; ++ui;
        if (wr == 1) PG8_BAR;
    }
    PG8_WAIT_V(0);
    PG8_BAR;
#undef PG8_SA
#undef PG8_SB
#undef PG8_STAGE_X
#undef PG8_STAGE_B
#undef PG8_STAGE_A
#undef PG8_TOKOFF
#undef PG8_LDA
#undef PG8_LDB
#undef PG8_MMA
#undef PG8_MMA1
#undef PG8_WAIT_V
#undef PG8_WAIT_L
#undef PG8_BAR
#undef PG8_SCHED
}
}
using pg8::Unit;

typedef f32x4 AccT[2][2][4][2];

struct EpiPool {
    static constexpr bool PERM = true;
    const float* x; const float* ctx; bf16_t* x1; const float* pb; const float* ps; const float* modv0;
    __device__ __forceinline__ void operator()(const AccT& acc, const Unit& u, int wr, int wc, int fr, int fq) const {
        const int bidx = u.pm < 64 ? (u.pm >> 3) : 8;
        const float* g1 = modv0 + (bidx * 6 + 2) * 1024;
        const float* src = u.pm < 64 ? x + (size_t)u.pm * 256 * 1024 : ctx + (size_t)(u.pm - 64) * 256 * 1024;
        bf16_t* dst = x1 + (size_t)u.pm * 256 * 1024;
        const int col0 = u.pn * 256 + wc * 32 + 8 * fq;
        f32x4 mul[2][2], add[2][2];
#pragma unroll
        for (int bj = 0; bj < 2; ++bj)
#pragma unroll
            for (int n = 0; n < 2; ++n) { const int c = col0 + bj * 128 + n * 4; const f32x4 bv = *(const f32x4*)(pb + c), sv = *(const f32x4*)(ps + c), gv = *(const f32x4*)(g1 + c);
                mul[bj][n] = sv * gv; add[bj][n] = bv * mul[bj][n]; }
#pragma unroll
        for (int ai = 0; ai < 2; ++ai)
#pragma unroll
            for (int m = 0; m < 4; ++m) { const size_t ro = (size_t)(ai * 128 + wr * 64 + m * 16 + fr) * 1024 + col0;
#pragma unroll
                for (int bj = 0; bj < 2; ++bj) { const f32x4 x0 = *(const f32x4*)(src + ro + bj * 128), x1v = *(const f32x4*)(src + ro + bj * 128 + 4);
                    *(u32x4*)(dst + ro + bj * 128) = pk8(x0 + acc[ai][bj][m][0] * mul[bj][0] + add[bj][0], x1v + acc[ai][bj][m][1] * mul[bj][1] + add[bj][1]); } }
    }
};

__device__ __forceinline__ f32x2 swiglu4_pk(f32x2 g, f32x2 u) {
    g.x = fminf(g.x, 7.0f); g.y = fminf(g.y, 7.0f);
    u.x = __builtin_amdgcn_fmed3f(u.x, -7.0f, 7.0f); u.y = __builtin_amdgcn_fmed3f(u.y, -7.0f, 7.0f);
    f32x2 t = g * (-1.702f * 1.4426950408889634f);
    t.x = __builtin_amdgcn_exp2f(t.x); t.y = __builtin_amdgcn_exp2f(t.y);
    t = t + 1.0f;
    t.x = __builtin_amdgcn_rcpf(t.x); t.y = __builtin_amdgcn_rcpf(t.y);
    return (u * 4.0f + 4.0f) * (g * t);
}
struct EpiGu {
    static constexpr bool PERM = true;
    unsigned char* act; const LAS float* biasl;
    __device__ __forceinline__ void operator()(const AccT& acc, const Unit& u, int wr, int wc, int fr, int fq) const {
        const LAS float* bias = biasl + u.nt * 256 + wc * 32 + 8 * fq; const int gcol0 = u.pn * 128 + wc * 32 + 8 * fq;
        f32x4 bg[2], bu[2];
#pragma unroll
        for (int n = 0; n < 2; ++n) { bg[n] = *(const LAS f32x4*)(bias + 4 * n); bu[n] = *(const LAS f32x4*)(bias + 128 + 4 * n); }
        unsigned char* ap = act + (size_t)u.pm * 256 * 1024 + (size_t)(wr * 64 + (fq & 1) * 16 + fr) * 1024 + u.pn * 128 + wc * 32 + 16 * (fq >> 1);
#pragma unroll
        for (int ai = 0; ai < 2; ++ai)
#pragma unroll
            for (int mp = 0; mp < 2; ++mp) {
                u32x2 w[2];
#pragma unroll
                for (int mo = 0; mo < 2; ++mo) { const int m = 2 * mp + mo;
#pragma unroll
                    for (int n = 0; n < 2; ++n) { const f32x4 gv = acc[ai][0][m][n] * (1.0f / 512.0f) + bg[n], uv = acc[ai][1][m][n] * (1.0f / 512.0f) + bu[n];
                        const f32x2 a0 = swiglu4_pk((f32x2){gv.x, gv.y}, (f32x2){uv.x, uv.y}), a1 = swiglu4_pk((f32x2){gv.z, gv.w}, (f32x2){uv.z, uv.w});
                        int p = __builtin_amdgcn_cvt_pk_fp8_f32(a0.x, a0.y, 0, false); p = __builtin_amdgcn_cvt_pk_fp8_f32(a1.x, a1.y, p, true); w[mo][n] = (unsigned)p; } }
                const auto r0 = __builtin_amdgcn_permlane16_swap(w[0].x, w[1].x, false, false), r1 = __builtin_amdgcn_permlane16_swap(w[0].y, w[1].y, false, false);
                const u32x4 o = {r0[0], r1[0], r0[1], r1[1]};
                *(u32x4*)(ap + (size_t)(ai * 128 + mp * 32) * 1024) = o; __builtin_amdgcn_sched_barrier(0); }
    }
};
struct EpiDown {
    static constexpr bool PERM = true;
    unsigned char* ys; const LAS float* biasl; const LAS int* aidl;
    __device__ __forceinline__ void operator()(const AccT& acc, const Unit& u, int wr, int wc, int fr, int fq) const {
        const LAS float* bias = biasl + u.nt * 256 + wc * 64 + 16 * fq; const int col0 = u.pn * 256 + wc * 64 + 16 * fq;
        f32x4 bv[4];
#pragma unroll
        for (int q = 0; q < 4; ++q) bv[q] = *(const LAS f32x4*)(bias + 4 * q) * 16.0f;
#pragma unroll
        for (int ai = 0; ai < 2; ++ai)
#pragma unroll
            for (int m = 0; m < 4; ++m) { const int r = ai * 128 + wr * 64 + m * 16 + fr; const int aid = aidl[u.nt * 256 + r]; const bool valid = aid >= 0;
                if (valid) { u32x4 w;
#pragma unroll
                    for (int bj = 0; bj < 2; ++bj)
#pragma unroll
                        for (int n = 0; n < 2; ++n) w[2 * bj + n] = pk_fp8x4(acc[ai][bj][m][n] * (1.0f / 16.0f) + bv[2 * bj + n]);
                    *(u32x4*)(ys + (size_t)aid * 1024 + col0) = w; } __builtin_amdgcn_sched_barrier(0); }
    }
};
__device__ __forceinline__ void row_bk(int row, int& b, int& key) { if (row < NL) { b = row >> 11; key = CTXL + (row & 2047); } else { const int r = row - NL; b = r >> 8; key = r & 255; } }
__device__ __forceinline__ void rope_rot(f32x4 x1, f32x4 x2, const f32x2* rope, int pos, int fq, bool rot, f32x4& o1, f32x4& o2) {
    o1 = x1; o2 = x2;
    if (rot) {
#pragma unroll
        for (int j = 0; j < 4; ++j) { const f32x2 cs = rope[pos * 16 + 4 * fq + j]; o1[j] = x1[j] * cs.x - x2[j] * cs.y; o2[j] = x2[j] * cs.x + x1[j] * cs.y; } }
}
struct EpiP1 {
    static constexpr bool PERM = true;
    unsigned char* qa; unsigned char* ckv; float* ssq;
    __device__ __forceinline__ void operator()(const AccT& acc, const Unit& u, int wr, int wc, int fr, int fq) const {
        const int row0 = u.pm * 256 + wr * 64 + fr;
        unsigned char* dst = u.pn < 2 ? qa : ckv; const int ld = u.pn < 2 ? 512 : 256, colt = (u.pn < 2 ? u.pn * 256 : 0) + wc * 32 + 8 * fq;
#pragma unroll
        for (int ai = 0; ai < 2; ++ai)
#pragma unroll
            for (int m = 0; m < 4; ++m) { const int row = row0 + ai * 128 + m * 16; float ss = 0.f;
#pragma unroll
                for (int bj = 0; bj < 2; ++bj) { const f32x4 v0 = acc[ai][bj][m][0] * (1.0f / 512.0f), v1 = acc[ai][bj][m][1] * (1.0f / 512.0f);
                    ss += (v0[0] * v0[0] + v0[1] * v0[1]) + (v0[2] * v0[2] + v0[3] * v0[3]) + (v1[0] * v1[0] + v1[1] * v1[1]) + (v1[2] * v1[2] + v1[3] * v1[3]);
                    *(u32x2*)(dst + (size_t)row * ld + colt + bj * 128) = pk_fp8x8(v0, v1, 8.0f); }
                ss += __shfl_xor(ss, 16); ss += __shfl_xor(ss, 32);
                if (fq == 0) ssq[(size_t)(u.pn * 4 + wc) * NT + row] = ss; }
    }
};
struct EpiKpe {
    static constexpr bool PERM = true;
    unsigned char* Kb; const f32x2* rope;
    __device__ __forceinline__ void operator()(const AccT& acc, const Unit& u, int wr, int wc, int fr, int fq) const {
        if (wc >= 2) return;
        const int row0 = u.pm * 256 + wr * 64 + fr;
#pragma unroll
        for (int ai = 0; ai < 2; ++ai)
#pragma unroll
            for (int m = 0; m < 4; ++m) { const int row = row0 + ai * 128 + m * 16; int b, key; row_bk(row, b, key);
                const int l = row & 2047, pos = wc == 0 ? (l >> 6) : (l & 63);
                f32x4 o1, o2; rope_rot(acc[ai][0][m][0] * (1.0f / 512.0f), acc[ai][0][m][1] * (1.0f / 512.0f), rope, pos, fq, row < NL, o1, o2);
                const u32x2 w = pk_fp8x8(o1, o2, 4.0f);
                unsigned char* kd = Kb + ((size_t)(b * NH) * SKV + key) * DQK + DNOPE + wc * 32 + 8 * fq;
#pragma unroll
                for (int h = 0; h < NH; ++h) *(u32x2*)(kd + (size_t)h * SKV * DQK) = w; }
    }
};
struct EpiUq {
    static constexpr bool PERM = true;
    unsigned char* Q; const LAS float* rinvl; const f32x2* rope;
    __device__ __forceinline__ void operator()(const AccT& acc, const Unit& u, int wr, int wc, int fr, int fq) const {
#pragma unroll
        for (int ai = 0; ai < 2; ++ai)
#pragma unroll
            for (int m = 0; m < 4; ++m) { const int rl = ai * 128 + wr * 64 + m * 16 + fr, row = u.pm * 256 + rl;
                const float rinv = rinvl[u.mt * 256 + rl];
                const int b = row >> 11, l = row & 2047;
#pragma unroll
                for (int bj = 0; bj < 2; ++bj) { const int cb = 8 * u.pn + 4 * bj + wc, head = cb / 6, wb = cb % 6;
                    unsigned char* dr = Q + ((size_t)(b * NH + head) * SEQ + l) * DQK;
                    const f32x4 v0 = acc[ai][bj][m][0] * rinv, v1 = acc[ai][bj][m][1] * rinv;
                    if (wb < 4) *(u32x2*)(dr + wb * 32 + 8 * fq) = pk_fp8x8(v0, v1, 4.0f);
                    else { const int axis = wb - 4, pos = axis == 0 ? (l >> 6) : (l & 63); f32x4 o1, o2; rope_rot(v0, v1, rope, pos, fq, true, o1, o2);
                        *(u32x2*)(dr + DNOPE + axis * 32 + 8 * fq) = pk_fp8x8(o1, o2, 4.0f); } } }
    }
};
struct EpiUkv {
    static constexpr bool PERM = true;
    unsigned char* Kb; unsigned char* Vb; const LAS float* rinvl;
    __device__ __forceinline__ void operator()(const AccT& acc, const Unit& u, int wr, int wc, int fr, int fq) const {
#pragma unroll
        for (int ai = 0; ai < 2; ++ai)
#pragma unroll
            for (int m = 0; m < 4; ++m) { const int rl = ai * 128 + wr * 64 + m * 16 + fr, row = u.pm * 256 + rl;
                const float rinv = rinvl[u.mt * 256 + rl];
                int b, key; row_bk(row, b, key);
                const size_t kr = (size_t)(b * NH + u.pn) * SKV + key;
                { const f32x4 v0 = acc[ai][0][m][0] * rinv, v1 = acc[ai][0][m][1] * rinv; *(u32x2*)(Kb + kr * DQK + wc * 32 + 8 * fq) = pk_fp8x8(v0, v1, 4.0f); }
                { const f32x4 v0 = acc[ai][1][m][0] * rinv, v1 = acc[ai][1][m][1] * rinv;
                  const int w6 = key & 63, kk = 32 * ((w6 >> 2) & 1) + 16 * (w6 >> 5) + (w6 & 3) + 4 * ((w6 >> 3) & 3);
                  unsigned char* vp = Vb + (((size_t)(b * NH + u.pn) * (SKV / 64) + (key >> 6)) * DV + wc * 32 + 8 * fq) * 64 + kk;
                  const unsigned q0 = pk_fp8x4(v0 * 16.0f), q1 = pk_fp8x4(v1 * 16.0f);
                  vp[0] = (unsigned char)q0; vp[64] = (unsigned char)(q0 >> 8); vp[128] = (unsigned char)(q0 >> 16); vp[192] = (unsigned char)(q0 >> 24);
                  vp[256] = (unsigned char)q1; vp[320] = (unsigned char)(q1 >> 8); vp[384] = (unsigned char)(q1 >> 16); vp[448] = (unsigned char)(q1 >> 24); } }
    }
};
struct EpiWo {
    static constexpr bool PERM = true;
    const bf16_t* x2; bf16_t* x3; const float* modv1;
    __device__ __forceinline__ void operator()(const AccT& acc, const Unit& u, int wr, int wc, int fr, int fq) const {
        const float* g1 = modv1 + ((u.pm >> 3) * 6 + 2) * 1024; const int col0 = u.pn * 256 + wc * 32 + 8 * fq;
        f32x4 gv[2][2];
#pragma unroll
        for (int bj = 0; bj < 2; ++bj)
#pragma unroll
            for (int n = 0; n < 2; ++n) gv[bj][n] = *(const f32x4*)(g1 + col0 + bj * 128 + n * 4) * (1.0f / 4096.0f);
#pragma unroll
        for (int ai = 0; ai < 2; ++ai)
#pragma unroll
            for (int m = 0; m < 4; ++m) { const size_t ro = (size_t)(u.pm * 256 + ai * 128 + wr * 64 + m * 16 + fr) * 1024 + col0;
#pragma unroll
                for (int bj = 0; bj < 2; ++bj) { f32x4 xa, xb; unpk8(*(const u32x4*)(x2 + ro + bj * 128), xa, xb);
                    *(u32x4*)(x3 + ro + bj * 128) = pk8(xa + acc[ai][bj][m][0] * gv[bj][0], xb + acc[ai][bj][m][1] * gv[bj][1]); } }
    }
};
struct EpiProj2 {
    static constexpr bool PERM = true;
    EpiKpe k; EpiUq q; EpiUkv v;
    __device__ __forceinline__ void operator()(const AccT& acc, const Unit& u, int wr, int wc, int fr, int fq) const {
        if (u.e == 0) k(acc, u, wr, wc, fr, fq); else if (u.e == 1) q(acc, u, wr, wc, fr, fq); else v(acc, u, wr, wc, fr, fq);
    }
};
struct KpeSched {
    int c; const char* A; const char* B;
    __device__ __forceinline__ bool next(int i, Unit& u) const {
        if (i > 0 || c >= NT / 256) return false;
        u.pm = c; u.pn = 3; u.e = 0; u.mt = 0; u.nv = 256; u.nt = 0; u.A = A + (size_t)c * 256 * 1024; u.B = B; return true;
    }
};
struct Proj2Sched {
    const LAS int* tab; int n;
    __device__ __forceinline__ bool next(int i, Unit& u) const {
        if (i >= n) return false;
        u.pm = __builtin_amdgcn_readfirstlane(tab[8 * i]); u.pn = __builtin_amdgcn_readfirstlane(tab[8 * i + 1]); u.e = __builtin_amdgcn_readfirstlane(tab[8 * i + 2]); u.nt = __builtin_amdgcn_readfirstlane(tab[8 * i + 3]);
        u.mt = i; u.nv = 256;
        const unsigned alo = __builtin_amdgcn_readfirstlane(tab[8 * i + 4]), ahi = __builtin_amdgcn_readfirstlane(tab[8 * i + 5]), blo = __builtin_amdgcn_readfirstlane(tab[8 * i + 6]), bhi = __builtin_amdgcn_readfirstlane(tab[8 * i + 7]);
        u.A = (const char*)(((unsigned long long)ahi << 32) | alo); u.B = (const char*)(((unsigned long long)bhi << 32) | blo); return true;
    }
};

namespace att {
constexpr int QBLK = 32, KVBLK = 64, KROW = 208;
constexpr float SCALE = 0.07216878364870322f / 16.0f;
constexpr float THR = 4.f, PSH = 3.f;
constexpr int NST = 3, SHM_V = KVBLK * DV, SHM_K = KVBLK * KROW, LDS_NEED = NST * SHM_V + NST * SHM_K + NWAVES * 64 * 4;
#define SBAR() __builtin_amdgcn_sched_barrier(0)
__device__ __forceinline__ int crow(int r, int hi) { return (r & 3) + 8 * (r >> 2) + 4 * hi; }
__device__ __forceinline__ void partialSM(f32x16& p0, f32x16& p1, float& m_reg, float& mn, float& alpha) {
    constexpr float C = SCALE * 1.4426950408889634f;
    float pmax = p0[0];
#pragma unroll
    for (int r = 1; r < 16; ++r) pmax = fmaxf(pmax, p0[r]);
#pragma unroll
    for (int r = 0; r < 16; ++r) pmax = fmaxf(pmax, p1[r]);
    { auto rr = __builtin_amdgcn_permlane32_swap(__float_as_uint(pmax), __float_as_uint(pmax), false, false);
      pmax = fmaxf(__uint_as_float(rr[0]), __uint_as_float(rr[1])); }
    if (__builtin_expect(__all(pmax - m_reg <= THR / SCALE), 1)) { mn = m_reg; alpha = 1.f; }
    else { mn = fmaxf(m_reg, pmax); alpha = __builtin_amdgcn_exp2f((m_reg - mn) * C); m_reg = mn; }
    const float mnC = PSH - mn * C;
#pragma unroll
    for (int r = 0; r < 16; ++r) p0[r] = fmaf(p0[r], C, mnC);
#pragma unroll
    for (int r = 0; r < 16; ++r) p1[r] = fmaf(p1[r], C, mnC);
#pragma unroll
    for (int r = 0; r < 16; ++r) p0[r] = __builtin_amdgcn_exp2f(p0[r]);
}
typedef int i32x8a __attribute__((ext_vector_type(8)));
typedef int i32x4a __attribute__((ext_vector_type(4)));
template <int VAR = 0> __device__ __forceinline__ void finishSM(f32x16& p0, f32x16& p1, i32x8a& pf) {
    if constexpr (!(VAR & 1)) {
#pragma unroll
    for (int r = 0; r < 16; ++r) p1[r] = __builtin_amdgcn_exp2f(p1[r]); }
#pragma unroll
    for (int i = 0; i < 4; ++i) { int a = __builtin_amdgcn_cvt_pk_fp8_f32(p0[4 * i], p0[4 * i + 1], 0, false); a = __builtin_amdgcn_cvt_pk_fp8_f32(p0[4 * i + 2], p0[4 * i + 3], a, true); pf[i] = a;
        int c = __builtin_amdgcn_cvt_pk_fp8_f32(p1[4 * i], p1[4 * i + 1], 0, false); c = __builtin_amdgcn_cvt_pk_fp8_f32(p1[4 * i + 2], p1[4 * i + 3], c, true); pf[4 + i] = c; }
}
__device__ __forceinline__ void qkt(f32x16& p0, f32x16& p1, const LAS unsigned char* Ks, const i32x8a* qr, int r32, int hi) {
    p0 = f32x16{}; p1 = f32x16{};
#pragma unroll
    for (int c = 0; c < 3; ++c) { const int cb = c * 64 + hi * 32;
        const i32x4a a0 = *(const LAS i32x4a*)(Ks + r32 * KROW + cb), a1 = *(const LAS i32x4a*)(Ks + r32 * KROW + cb + 16);
        const i32x4a b0 = *(const LAS i32x4a*)(Ks + (32 + r32) * KROW + cb), b1 = *(const LAS i32x4a*)(Ks + (32 + r32) * KROW + cb + 16);
        p0 = __builtin_amdgcn_mfma_scale_f32_32x32x64_f8f6f4(__builtin_shufflevector(a0, a1, 0, 1, 2, 3, 4, 5, 6, 7), qr[c], p0, 0, 0, 0, 0, 0, 0);
        p1 = __builtin_amdgcn_mfma_scale_f32_32x32x64_f8f6f4(__builtin_shufflevector(b0, b1, 0, 1, 2, 3, 4, 5, 6, 7), qr[c], p1, 0, 0, 0, 0, 0, 0); }
}
struct VF8 { i32x8a b[4]; };
__device__ __forceinline__ void pv_reads8(VF8& f, const LAS unsigned char* Vs, int r32, int hi) {
    const int sw = (r32 >> 2) & 3; const LAS unsigned char* p = Vs + r32 * 64;
#pragma unroll
    for (int d0 = 0; d0 < 4; ++d0) { const i32x4a x = *(const LAS i32x4a*)(p + d0 * 2048 + (((2 * hi) ^ sw) << 4)), y = *(const LAS i32x4a*)(p + d0 * 2048 + (((2 * hi + 1) ^ sw) << 4));
        f.b[d0] = __builtin_shufflevector(x, y, 0, 1, 2, 3, 4, 5, 6, 7); }
}
__device__ __forceinline__ void pv_all8(f32x16* o, f32x16& ol, const VF8& f, i32x8a pf, i32x8a ones8) {
#pragma unroll
    for (int d0 = 0; d0 < 4; ++d0) o[d0] = __builtin_amdgcn_mfma_scale_f32_32x32x64_f8f6f4(pf, f.b[d0], o[d0], 0, 0, 0, 0, 0, 0);
    ol = __builtin_amdgcn_mfma_scale_f32_32x32x64_f8f6f4(pf, ones8, ol, 0, 0, 0, 0, 0, 0);
}
template <int VAR = 0>
__device__ __forceinline__ void attn_unit(const unsigned char* __restrict__ Qb, const unsigned char* __restrict__ Kh, const unsigned char* __restrict__ Vh, unsigned char* __restrict__ Ob, LAS unsigned char* lds, int wave_s) {
    const int lane = opq(lane_id()), wid = wave_s, tid = wid * 64 + lane, r32 = lane & 31, hi = lane >> 5;
    LAS unsigned char* V_lds = lds; LAS unsigned char* K_lds = lds + NST * SHM_V;
    LAS float* ws = (LAS float*)(lds + NST * SHM_V + NST * SHM_K) + wid * 64; LAS float* li_l = ws; LAS float* al_l = ws + 32;
    float m_reg = -1e30f; f32x16 o[4] = {}, ol = {}; i32x8a qr[3];
    i32x8a ones8; { int one_ = 0x38383838; asm volatile("" : "+v"(one_)); ones8 = (i32x8a){one_, one_, one_, one_, one_, one_, one_, one_}; }
    const unsigned char* Qw = Qb + (size_t)(wid * QBLK + r32) * DQK + hi * 32;
#pragma unroll
    for (int c = 0; c < 3; ++c) { const i32x4a q0 = *(const i32x4a*)(Qw + c * 64), q1 = *(const i32x4a*)(Qw + c * 64 + 16); qr[c] = __builtin_shufflevector(q0, q1, 0, 1, 2, 3, 4, 5, 6, 7); }
    unsigned kofs[2], vofs;
#pragma unroll
    for (int sl = 0; sl < 2; ++sl) { const int p = 64 * (wid + 8 * sl) + lane, row = (p * 5042) >> 16, c = p - 13 * row;
        kofs[sl] = (unsigned)(row * DQK + (c < 12 ? c : 11) * 16); }
    { const int p = 64 * wid + lane, d = p >> 2, c = (p & 3) ^ ((d >> 2) & 3); vofs = (unsigned)(d * 64 + c * 16); }
#define SDMA(t, st) do { if constexpr (!(VAR & 16)) { \
    const char* kb_ = uni_ptr((const char*)Kh + (size_t)(t) * KVBLK * DQK); asm volatile("" : "+s"(kb_)); const char* vg_ = uni_ptr((const char*)Vh + (size_t)(t) * SHM_V); asm volatile("" : "+s"(vg_)); \
    LAS unsigned char* kd_ = K_lds + (st) * SHM_K + wid * 1024; LAS unsigned char* vd_ = V_lds + (st) * SHM_V + wid * 1024; \
    __builtin_amdgcn_global_load_lds((const unsigned*)(kb_ + kofs[0]), (LAS unsigned*)kd_, 16, 0, 0); \
    if (wid < 5) __builtin_amdgcn_global_load_lds((const unsigned*)(kb_ + kofs[1]), (LAS unsigned*)(kd_ + 8192), 16, 0, 0); \
    __builtin_amdgcn_global_load_lds((const unsigned*)(vg_ + vofs), (LAS unsigned*)vd_, 16, 0, 0); } } while (0)
#define SWAIT() asm volatile("s_waitcnt vmcnt(0)" ::: "memory")
#define RESC(a) do { if (__any((a) < 1.f)) { if (hi == 0) al_l[r32] = (a); asm volatile("s_waitcnt lgkmcnt(0)" ::: "memory"); \
    _Pragma("unroll") for (int r = 0; r < 16; ++r) { const float a_ = al_l[crow(r, hi)]; ol[r] *= a_; _Pragma("unroll") for (int d = 0; d < 4; ++d) o[d][r] *= a_; } } } while (0)
    f32x16 pA0, pA1, pB0, pB1; float mnA, alA, alB; i32x8a pf; constexpr int NTL = SKV / KVBLK;
    SDMA(0, 0); SDMA(1, 1); SWAIT(); __syncthreads();
    qkt(pA0, pA1, K_lds, qr, r32, hi); partialSM(pA0, pA1, m_reg, mnA, alA);
    VF8 vf; float pmx;
    int sV = 0, sK = 1, sW = 2;
#define MM8(D0) do { if constexpr (!(VAR & 2)) o[D0] = __builtin_amdgcn_mfma_scale_f32_32x32x64_f8f6f4(pf, vf.b[D0], o[D0], 0, 0, 0, 0, 0, 0); SBAR(); } while (0)
#define SL(...) do { __VA_ARGS__; SBAR(); } while (0)
#define MAX3(a, x, y) a = fmaxf(fmaxf(a, x), y)
#define PIN1(x) asm volatile("" : "+v"(x))
#define PINV(P) asm volatile("" : "+v"(P))
#define FM(P, r) do { float t_ = P[r]; asm volatile("v_fma_f32 %0, %0, %1, %2" : "+v"(t_) : "v"(cvm_), "v"(mnc_)); P[r] = t_; } while (0)
#define FM4(P, r) do { FM(P, r); FM(P, r + 1); FM(P, r + 2); FM(P, r + 3); } while (0)
#define EX(P, r) do { if constexpr (!(VAR & 1)) P[r] = __builtin_amdgcn_exp2f(P[r]); } while (0)
#define EX4(P, r) do { EX(P, r); EX(P, r + 1); EX(P, r + 2); EX(P, r + 3); } while (0)
    constexpr float CSM = SCALE * 1.4426950408889634f; float cvm_ = CSM; asm volatile("" : "+v"(cvm_)); float ma_, mb_, mnc_;
#define TILE(PN0, PN1, PO0, PO1, ALO, ALN, NEXTT) do { \
        SBAR(); SDMA(NEXTT, sW); SBAR(); \
        if constexpr (!(VAR & 4)) qkt(PN0, PN1, K_lds + sK * SHM_K, qr, r32, hi); else { PN0 = f32x16{}; PN1 = f32x16{}; asm volatile("" : "+v"(PN0), "+v"(PN1)); } \
        pv_reads8(vf, V_lds + sV * SHM_V, r32, hi); \
        finishSM<VAR>(PO0, PO1, pf); SBAR(); \
        MM8(0); SL(ma_ = fmaxf(fmaxf(PN0[0], PN0[1]), PN0[2]); MAX3(ma_, PN0[3], PN0[4]); MAX3(ma_, PN0[5], PN0[6]); MAX3(ma_, PN0[7], PN0[8]); MAX3(ma_, PN0[9], PN0[10]); MAX3(ma_, PN0[11], PN0[12]); MAX3(ma_, PN0[13], PN0[14]); \
            mb_ = fmaxf(fmaxf(PN0[15], PN1[0]), PN1[1]); MAX3(mb_, PN1[2], PN1[3]); MAX3(mb_, PN1[4], PN1[5]); MAX3(mb_, PN1[6], PN1[7]); MAX3(mb_, PN1[8], PN1[9]); MAX3(mb_, PN1[10], PN1[11]); MAX3(mb_, PN1[12], PN1[13]); MAX3(mb_, PN1[14], PN1[15]); \
            pmx = fmaxf(ma_, mb_); { auto rr_ = __builtin_amdgcn_permlane32_swap(__float_as_uint(pmx), __float_as_uint(pmx), false, false); pmx = fmaxf(__uint_as_float(rr_[0]), __uint_as_float(rr_[1])); } PIN1(pmx)); \
        MM8(1); SL({ const bool keep_ = __all(pmx - m_reg <= THR / SCALE); const float mn_ = keep_ ? m_reg : fmaxf(m_reg, pmx); ALN = keep_ ? 1.f : __builtin_amdgcn_exp2f((m_reg - mn_) * CSM); m_reg = mn_; mnc_ = PSH - mn_ * CSM; } PIN1(mnc_); PIN1(ALN); \
            FM4(PN0, 0); FM4(PN0, 4); FM4(PN0, 8); FM4(PN0, 12)); \
        MM8(2); SL(FM4(PN1, 0); FM4(PN1, 4); FM4(PN1, 8); FM4(PN1, 12); EX4(PN0, 0); PINV(PN0)); \
        MM8(3); SL(EX4(PN0, 4); EX4(PN0, 8); PINV(PN0)); \
        if constexpr (!(VAR & 2)) ol = __builtin_amdgcn_mfma_scale_f32_32x32x64_f8f6f4(pf, ones8, ol, 0, 0, 0, 0, 0, 0); SBAR(); SL(EX4(PN0, 12); PINV(PN0)); \
        asm volatile("" : "+v"(PN0), "+v"(PN1)); SBAR(); \
        RESC(ALN); SWAIT(); if constexpr (!(VAR & 8)) __syncthreads(); \
        sV = sK; sK = sW; sW = sW == NST - 1 ? 0 : sW + 1; } while (0)
    for (int j = 1; j + 1 < NTL; j += 2) {
        TILE(pB0, pB1, pA0, pA1, alA, alB, j + 1);
        TILE(pA0, pA1, pB0, pB1, alB, alA, j + 2);
    }
#undef TILE
#undef MM8
#undef SL
#undef MAX3
#undef PIN1
#undef PINV
#undef FM
#undef FM4
#undef EX
#undef EX4
    SBAR(); qkt(pB0, pB1, K_lds + sK * SHM_K, qr, r32, hi);
    pv_reads8(vf, V_lds + sV * SHM_V, r32, hi);
    finishSM(pA0, pA1, pf); SBAR();
    pv_all8(o, ol, vf, pf, ones8); partialSM(pB0, pB1, m_reg, mnA, alB);
    RESC(alB);
    pv_reads8(vf, V_lds + sK * SHM_V, r32, hi);
    finishSM(pB0, pB1, pf); SBAR();
    pv_all8(o, ol, vf, pf, ones8);
    float rli[16];
#pragma unroll
    for (int r = 0; r < 16; ++r) rli[r] = __builtin_amdgcn_rcpf(ol[r]);
    __syncthreads();
    const int tid2 = opq(tid), wid2 = tid2 >> 6, lane2 = tid2 & 63, r32b = lane2 & 31, hib = lane2 >> 5;
    LAS unsigned char* ost = lds + wid2 * 4096;
#pragma unroll
    for (int r = 0; r < 16; ++r) { const int orow = crow(r, hib);
#pragma unroll
        for (int d0 = 0; d0 < 4; ++d0) { const float v = clamp8(o[d0][r] * rli[r] * 4.0f);     ost[orow * 128 + d0 * 32 + r32b] = (unsigned char)(__builtin_amdgcn_cvt_pk_fp8_f32(v, v, 0, false) & 0xff); } }
    asm volatile("s_waitcnt lgkmcnt(0)" ::: "memory");
    unsigned char* Ow = Ob + (size_t)(wid2 * QBLK) * 1024;
#pragma unroll
    for (int i = 0; i < 4; ++i) { const int id = lane2 + 64 * i, rr = id >> 3, ch = id & 7;
        const u32x4 w = *(const LAS u32x4*)(ost + rr * 128 + ch * 16);
        gst16(Ow + (size_t)rr * 1024 + ch * 16, (u32x4)(w)); }
#undef SDMA
#undef SWAIT
#undef RESC
}
}

struct Frame {
    LAS unsigned char* lds; LAS unsigned char* misc;
    unsigned* ctl; unsigned char* ws;
    int tid, lane, wave, vcu, G;
    const float* in[25];
    float* out;
};
struct Args { const float* in[25]; float* out; unsigned char* ws; int ph_lo, ph_hi; };

__device__ __forceinline__ void transpose_item(const float* W, int N, int K, bf16_t* WT, int k0, int n0, int rbase, bool perm, const float* kscale, LAS float* scr, int lane) {
#pragma unroll 8
    for (int i = 0; i < 32; ++i) { const int kk = 2 * i + (lane >> 5); float v = W[(size_t)(k0 + kk) * N + n0 + (lane & 31)]; if (kscale) v *= kscale[k0 + kk]; scr[kk * 33 + (lane & 31)] = v; }
    LDS_WAIT(); asm volatile("" ::: "memory");
    const int c = lane & 7;
#pragma unroll
    for (int j = 0; j < 4; ++j) { const int n = (lane >> 3) + 8 * j; const LAS float* s = scr + (8 * c) * 33 + n;
        u32x4 o; o.x = pk2(s[0 * 33], s[1 * 33]); o.y = pk2(s[2 * 33], s[3 * 33]); o.z = pk2(s[4 * 33], s[5 * 33]); o.w = pk2(s[6 * 33], s[7 * 33]);
        const int orow = rbase + (perm ? pg8::perm32(n) : n);
        gst16(WT + (size_t)orow * K + k0 + 8 * c, (u32x4)(o)); }
    LDS_WAIT(); asm volatile("" ::: "memory");
}

struct T8Item { const float* W; unsigned char* WT; int N, K, k0, n0, rbase, perm; const float* kscale; };
__device__ __forceinline__ void t8_load(const T8Item& it, f32x4 (&v)[16], int lane) {
    const int kr = lane >> 3, nq = (lane & 7) * 4;
#pragma unroll
    for (int i = 0; i < 16; ++i) v[i] = __builtin_nontemporal_load((const f32x4*)(it.W + (size_t)(it.k0 + 8 * i + kr) * it.N + it.n0 + nq));
}
__device__ __forceinline__ void t8_finish(const T8Item& it, const f32x4 (&v)[16], float qs, LAS float* scr, int lane) {
    const int kr = lane >> 3, nq = (lane & 7) * 4;
#pragma unroll
    for (int i = 0; i < 16; ++i) { LAS float* d = scr + (8 * i + kr) * 33 + nq; d[0] = v[i].x; d[1] = v[i].y; d[2] = v[i].z; d[3] = v[i].w; }
    LDS_WAIT(); asm volatile("" ::: "memory");
    const int c = lane & 7;
#pragma unroll
    for (int j = 0; j < 4; ++j) { const int n = (lane >> 3) + 8 * j; const LAS float* s = scr + (16 * c) * 33 + n;
        u32x4 o;
#pragma unroll
        for (int q = 0; q < 4; ++q) { f32x4 v = (f32x4){s[(4 * q) * 33], s[(4 * q + 1) * 33], s[(4 * q + 2) * 33], s[(4 * q + 3) * 33]} * qs; if (it.kscale) v = v * *(const f32x4*)(it.kscale + it.k0 + 16 * c + 4 * q); o[q] = pk_fp8x4(v); }
        int orow;
        if (it.perm == 2) { const int a = (it.n0 & 255) + n;
            orow = (it.n0 & ~255) + 128 * ((a >> 3) & 1) + 32 * (a >> 6) + 8 * ((a >> 4) & 3) + (a & 7); }
        else orow = it.rbase + (it.perm ? pg8::perm32(n) : n);
        gst16(it.WT + (size_t)orow * it.K + it.k0 + 16 * c, (u32x4)(o)); }
    LDS_WAIT(); asm volatile("" ::: "memory");
}
constexpr int I_GU8L = 32 * 8 * 64, I_DN8L = 32 * 8 * 32;
__device__ __forceinline__ T8Item t8_item(const Frame& F, int layer, int j) {
    T8Item it;
    if (j < I_GU8L) { const int r = layer * I_GU8L + j, mat = r / (8 * 64), q = r % (8 * 64), kb = q / 64, nb = q % 64, n0 = nb * 32;
        it.W = F.in[20] + (size_t)mat * 1024 * 2048; it.WT = F.ws + WS_WGU + (size_t)mat * 2048 * 1024; it.N = 2048; it.K = 1024; it.k0 = kb * 128; it.n0 = n0;
        it.rbase = ((n0 & 1023) >> 7) * 256 + (n0 >> 10) * 128 + (n0 & 127); it.perm = 0; it.kscale = nullptr; }
    else { const int r = layer * I_DN8L + (j - I_GU8L), mat = r / (8 * 32), q = r % (8 * 32), kb = q / 32, nb = q % 32;
        it.W = F.in[22] + (size_t)mat * 1024 * 1024; it.WT = F.ws + WS_WDN + (size_t)mat * 1024 * 1024; it.N = 1024; it.K = 1024; it.k0 = kb * 128; it.n0 = nb * 32; it.rbase = nb * 32; it.perm = 2; it.kscale = nullptr; }
    return it;
}
__device__ __forceinline__ void convert_experts(Frame& F, int layer, int j0, int j1) {
    const int lane = opq(lane_id());
    LAS float* scr = (LAS float*)(F.lds + F.wave * 16896);
    const int gw = F.vcu * NWAVES + F.wave, NGW = F.G * NWAVES;
    const int NBIG = j1;
    int it = j0 + gw; f32x4 va[16], vb[16]; T8Item ia, ib;
    if (it < NBIG) { ia = t8_item(F, layer, it); t8_load(ia, va, lane); }
    while (it < NBIG) {
        const int itn = it + NGW; if (itn < NBIG) { ib = t8_item(F, layer, itn); t8_load(ib, vb, lane); }
        t8_finish(ia, va, 64.f, scr, lane);
        it = itn; if (it >= NBIG) break;
        const int itn2 = it + NGW; if (itn2 < NBIG) { ia = t8_item(F, layer, itn2); t8_load(ia, va, lane); }
        t8_finish(ib, vb, 64.f, scr, lane);
        it = itn2; }
}

__device__ __forceinline__ void p0_prologue(Frame& F) {
    const float* c_in = F.in[1]; const float* cctx = F.in[3]; const float* ada_w = F.in[4]; const float* ada_b = F.in[5];
    float* modv = (float*)(F.ws + WS_MODV);
    if (F.vcu < 192) {
        LAS float* s = (LAS float*)F.lds;
        { float cv[18];
          const int tq = opq(F.tid);
#pragma unroll
          for (int j = 0; j < 18; ++j) { const int k = (tq + j * NTHR) & 1023; cv[j] = (j >> 1) < 8 ? c_in[(j >> 1) * 1024 + k] : cctx[k]; }
          __builtin_amdgcn_sched_barrier(0);
#pragma unroll
          for (int j = 0; j < 18; ++j) { const float v = cv[j]; s[F.tid + j * NTHR] = v / (1.0f + expf(-v)); } }
        __syncthreads();
        const int ln = opq(F.lane);
        const int col0 = F.vcu * 64, layer = col0 / 6144, nb = col0 % 6144, c16 = ln & 15, kq = ln >> 4;
        const float* wp = ada_w + (size_t)layer * 1024 * 6144 + nb + 4 * c16 + (size_t)(F.wave * 128 + kq) * 6144;
        f32x4 a[9];
#pragma unroll
        for (int b = 0; b < 9; ++b) a[b] = (f32x4){0.f, 0.f, 0.f, 0.f};
        const LAS float* sp = s + F.wave * 128 + kq;
#pragma unroll
        for (int hf = 0; hf < 2; ++hf) { f32x4 w[16];
#pragma unroll
            for (int i = 0; i < 16; ++i) w[i] = __builtin_nontemporal_load((const f32x4*)(wp + (size_t)(4 * (16 * hf + i)) * 6144));
            __builtin_amdgcn_sched_barrier(0);
#pragma unroll
            for (int i = 0; i < 16; ++i) {
#pragma unroll
                for (int b = 0; b < 9; ++b) a[b] += w[i] * sp[b * 1024 + 4 * (16 * hf + i)]; }
            __builtin_amdgcn_sched_barrier(0); }
        LAS float* red = (LAS float*)(F.lds + 40960);
#pragma unroll
        for (int b = 0; b < 9; ++b) *(LAS f32x4*)(red + ((F.wave * 4 + kq) * 9 + b) * 64 + 4 * c16) = a[b];
        __syncthreads();
        for (int i = F.tid; i < 9 * 64; i += NTHR) { const int b = i >> 6, l = i & 63; float t = 0.f;
#pragma unroll
            for (int p = 0; p < 32; ++p) t += red[(p * 9 + b) * 64 + l];
            const int nn = nb + l; modv[((size_t)layer * 9 + b) * 6144 + nn] = t + ada_b[layer * 6144 + nn]; }
        __syncthreads();
    }
    if (F.vcu == 192) {
        f32x2* rope = (f32x2*)(F.ws + WS_ROPE);
        for (int i = F.tid; i < 64 * 16; i += NTHR) { const int p = i >> 4, f = i & 15;
            double invf = 1.0; for (int q = 0; q < f; ++q) invf *= 0.56234132519034908;
            const double x = (double)p * invf, kk = __builtin_rint(x * 0.15915494309189535), r = (x - kk * 6.2831853071795862) , r2 = r * r;
            double sn = 0.0, cs = 0.0, ts = r, tc = 1.0;
#pragma unroll
            for (int n = 0; n < 14; ++n) { sn += ts; cs += tc; tc = -tc * r2 * (1.0 / (double)((2 * n + 1) * (2 * n + 2))); ts = -ts * r2 * (1.0 / (double)((2 * n + 2) * (2 * n + 3))); }
            rope[i] = (f32x2){(float)cs, (float)sn}; }
    }
    if (F.vcu >= 193 && F.vcu < 201) {
        const float* rw = F.in[18]; float* rwt = (float*)(F.ws + WS_RWT); const int g = (F.vcu - 193) * NTHR + opq(F.tid); float v[16];
#pragma unroll
        for (int j = 0; j < 16; ++j) v[j] = rw[g + 4096 * j];
#pragma unroll
        for (int j = 0; j < 16; ++j) { const int i = g + 4096 * j; rwt[(size_t)(i >> 15) * 32768 + (i & 31) * 1024 + ((i >> 5) & 1023)] = v[j]; }
    }
    if (F.vcu >= 201 && F.vcu < 209) {
        u32x4* z = (u32x4*)(F.ws + WS_WP1 + (size_t)832 * 1024);
        for (int i = (F.vcu - 201) * NTHR + F.tid; i < 192 * 64; i += 8 * NTHR) z[i] = (u32x4){0u, 0u, 0u, 0u};
    }
    if (F.vcu <= 192) return;
    LAS float* scr = (LAS float*)(F.lds + F.wave * 16896);
    const int gw = (F.vcu - 193) * NWAVES + F.wave, NGW = (F.G - 193) * NWAVES;
    constexpr int I_POOL = 4 * 4 * 8, I_DQ = 8 * 16, I_DKV = 8 * 10, I_UQ = 4 * 48, I_UKV = 2 * 64, I_WO = 8 * 32;
    constexpr int NITEMS = I_POOL + I_DQ + I_DKV + I_UQ + I_UKV + I_WO;
    for (int it = gw; it < NITEMS; it += NGW) {
        int r = it;
        if (r < I_POOL) { const int g = r / 32, q = r % 32, kb = q / 8, nb = q % 8;
            transpose_item(F.in[8] + (size_t)g * 256 * 256, 256, 256, (bf16_t*)(F.ws + WS_WPOOL) + (size_t)g * 256 * 256, kb * 64, nb * 32, nb * 32, false, nullptr, scr, F.lane); continue; } r -= I_POOL;
        if (r < I_DQ) { const int kb = r / 16, nb = r % 16; f32x4 vv[16];
            T8Item wi; wi.W = F.in[11]; wi.WT = F.ws + WS_WP1; wi.N = 512; wi.K = 1024; wi.k0 = kb * 128; wi.n0 = nb * 32; wi.rbase = nb * 32; wi.perm = 0; wi.kscale = nullptr;
            t8_load(wi, vv, F.lane); t8_finish(wi, vv, 64.f, scr, F.lane); continue; } r -= I_DQ;
        if (r < I_DKV) { const int kb = r / 10, nb = r % 10; f32x4 vv[16];
            T8Item wi; wi.W = F.in[14]; wi.WT = F.ws + WS_WP1; wi.N = 320; wi.K = 1024; wi.k0 = kb * 128; wi.n0 = nb * 32; wi.rbase = 512 + nb * 32; wi.perm = nb >= 8; wi.kscale = nullptr;
            t8_load(wi, vv, F.lane); t8_finish(wi, vv, 64.f, scr, F.lane); continue; } r -= I_DKV;
        if (r < I_UQ) { const int kb = r / 48, nb = r % 48; f32x4 vv[16];
            T8Item wi; wi.W = F.in[13]; wi.WT = F.ws + WS_WUQ; wi.N = 1536; wi.K = 512; wi.k0 = kb * 128; wi.n0 = nb * 32; wi.rbase = nb * 32; wi.perm = (nb % 6) >= 4; wi.kscale = F.in[12];
            t8_load(wi, vv, F.lane); t8_finish(wi, vv, 64.f, scr, F.lane); continue; } r -= I_UQ;
        if (r < I_UKV) { const int kb = r / 64, nb = r % 64; f32x4 vv[16];
            T8Item wi; wi.W = F.in[16]; wi.WT = F.ws + WS_WUKV; wi.N = 2048; wi.K = 256; wi.k0 = kb * 128; wi.n0 = nb * 32; wi.rbase = nb * 32; wi.perm = 0; wi.kscale = F.in[15];
            t8_load(wi, vv, F.lane); t8_finish(wi, vv, 64.f, scr, F.lane); continue; } r -= I_UKV;
        { const int kb = r / 32, nb = r % 32; f32x4 vv[16];
            T8Item wi; wi.W = F.in[17]; wi.WT = F.ws + WS_WO; wi.N = 1024; wi.K = 1024; wi.k0 = kb * 128; wi.n0 = nb * 32; wi.rbase = nb * 32; wi.perm = 0; wi.kscale = nullptr;
            t8_load(wi, vv, F.lane); t8_finish(wi, vv, 64.f, scr, F.lane); }
    }
}

__device__ __forceinline__ const float* xrow_ptr(const Frame& F, int row) { return row < NL ? F.in[0] + (size_t)row * D : F.in[2] + (size_t)(row - NL) * D; }

template <int W> __device__ __forceinline__ f32x4 win_sum(const Frame& F, const LAS float* rinv_l, int rbase, int base, int t, int Lseq, int col, int& cnt) {
    f32x4 v[W]; float w[W]; cnt = 0;
#pragma unroll
    for (int i = 0; i < W; ++i) { const int tt = t - W / 2 + i; const bool ok = tt >= 0 && tt < Lseq; const int tc = tt < 0 ? 0 : (tt >= Lseq ? Lseq - 1 : tt); const int rr = base + tc;
        v[i] = *(const f32x4*)(xrow_ptr(F, rr) + col); w[i] = ok ? rinv_l[rr - rbase] : 0.f; cnt += ok ? 1 : 0; }
    f32x4 s = (f32x4){0.f, 0.f, 0.f, 0.f};
#pragma unroll
    for (int i = 0; i < W; ++i) s += v[i] * w[i];
    return s;
}
__device__ __forceinline__ void p1_pooldiff(Frame& F) {
    const int rpb = (NT + F.G - 1) / F.G, r0 = F.vcu * rpb, r1 = min(NT, r0 + rpb);
    if (r0 >= r1) return;
    const int h0 = max(0, r0 - 8), h1 = min(NT, r1 + 8);
    LAS float* rinv_l = (LAS float*)(F.misc + M_RINV);
    for (int row = h0 + F.wave; row < h1; row += NWAVES) {
        const f32x4* xr = (const f32x4*)xrow_ptr(F, row) + F.lane; float s = 0.f;
#pragma unroll
        for (int j = 0; j < 4; ++j) { const f32x4 v = xr[64 * j]; s += (v.x * v.x + v.y * v.y) + (v.z * v.z + v.w * v.w); }
        s = wave_sum(s);
        if (F.lane == 0) rinv_l[row - h0] = 1.0f / sqrtf(s * (1.0f / D) + EPS);
    }
    __syncthreads();
    const float* ng = F.in[6];
    const float* modv = (const float*)(F.ws + WS_MODV);
    bf16_t* H = (bf16_t*)(F.ws + WS_H);
    const int rpw = (r1 - r0 + NWAVES - 1) / NWAVES, ra = r0 + rpw * F.wave, rb = min(r1, ra + rpw);
    f32x4 S[4] = {{0.f, 0.f, 0.f, 0.f}, {0.f, 0.f, 0.f, 0.f}, {0.f, 0.f, 0.f, 0.f}, {0.f, 0.f, 0.f, 0.f}}; int cnt[4] = {1, 1, 1, 1};
    for (int row = ra; row < rb; ++row) {
        int bidx, t, Lseq;
        if (row < NL) { bidx = row >> 11; t = row & 2047; Lseq = SEQ; } else { bidx = 8; t = (row - NL) & 255; Lseq = CTXL; }
        const int base = row - t; const float* xs = xrow_ptr(F, row);
        const float* s1 = modv + (bidx * 6 + 1) * 1024;
        const float rself = rinv_l[row - h0];
        f32x4 self[4];
#pragma unroll
        for (int j = 0; j < 4; ++j) self[j] = *(const f32x4*)(xs + 256 * j + 4 * F.lane);
        if (row == ra || t == 0) {
            S[0] = win_sum<2>(F, rinv_l, h0, base, t, Lseq, 4 * F.lane, cnt[0]);
            S[1] = win_sum<4>(F, rinv_l, h0, base, t, Lseq, 256 + 4 * F.lane, cnt[1]);
            S[2] = win_sum<8>(F, rinv_l, h0, base, t, Lseq, 512 + 4 * F.lane, cnt[2]);
            S[3] = win_sum<16>(F, rinv_l, h0, base, t, Lseq, 768 + 4 * F.lane, cnt[3]);
        } else {
            f32x4 va[4], vr[4]; float wa[4], wr_[4];
#pragma unroll
            for (int j = 0; j < 4; ++j) { const int hw = 1 << j;
                const int ta = t + hw - 1, tr = t - 1 - hw; const bool oka = ta < Lseq, okr = tr >= 0;
                const int rra = base + (oka ? ta : Lseq - 1), rrr = base + (okr ? tr : 0);
                va[j] = *(const f32x4*)(xrow_ptr(F, rra) + 256 * j + 4 * F.lane); vr[j] = *(const f32x4*)(xrow_ptr(F, rrr) + 256 * j + 4 * F.lane);
                wa[j] = oka ? rinv_l[rra - h0] : 0.f; wr_[j] = okr ? rinv_l[rrr - h0] : 0.f; cnt[j] += (oka ? 1 : 0) - (okr ? 1 : 0); }
#pragma unroll
            for (int j = 0; j < 4; ++j) S[j] += va[j] * wa[j] - vr[j] * wr_[j];
        }
#pragma unroll
        for (int j = 0; j < 4; ++j) { const int col = 256 * j + 4 * F.lane;
            const f32x4 gg = *(const f32x4*)(ng + col) * (*(const f32x4*)(s1 + col) + 1.0f);
            const f32x4 d = (S[j] * (1.0f / (float)cnt[j]) - self[j] * rself) * gg;
            u32x2 w; w.x = pk2(d.x, d.y); w.y = pk2(d.z, d.w);
            *(u32x2*)(H + (size_t)row * D + col) = w; }
    }
}

constexpr int DT_LD = 264, DT_TILE = 72 * DT_LD;
__device__ __forceinline__ void pool_block(Frame& F, bf16_t* X1) {
    const int rpb = (NT + F.G - 1) / F.G, r0 = F.vcu * rpb, r1 = min(NT, r0 + rpb), nr = r1 - r0;
    if (nr <= 0) return;
    const int h0 = max(0, r0 - 8), h1 = min(NT, r1 + 8);
    LAS float* rinv_l = (LAS float*)(F.misc + M_RINV);
    LAS bf16_t* dt = (LAS bf16_t*)F.lds;
    for (int rb = h0 + F.wave; rb < h1; rb += 6 * NWAVES) {
        f32x4 v[6][4];
#pragma unroll
        for (int q = 0; q < 6; ++q) { const int row = min(rb + q * NWAVES, h1 - 1); const f32x4* xr = (const f32x4*)xrow_ptr(F, row) + F.lane;
#pragma unroll
            for (int j = 0; j < 4; ++j) v[q][j] = xr[64 * j]; }
        __builtin_amdgcn_sched_barrier(0);
#pragma unroll
        for (int q = 0; q < 6; ++q) { const int row = rb + q * NWAVES; float s = 0.f;
#pragma unroll
            for (int j = 0; j < 4; ++j) s += (v[q][j].x * v[q][j].x + v[q][j].y * v[q][j].y) + (v[q][j].z * v[q][j].z + v[q][j].w * v[q][j].w);
            s = wave_sum(s);
            if (row < h1 && F.lane == 0) rinv_l[row - h0] = 1.0f / sqrtf(s * (1.0f / D) + EPS); }
    }
    __syncthreads();
    const float* ng = F.in[6]; const float* pb = F.in[9]; const float* ps = F.in[10];
    const float* modv = (const float*)(F.ws + WS_MODV);
    const bf16_t* Wp = (const bf16_t*)(F.ws + WS_WPOOL);
    const int lane = F.lane, n16 = lane & 15, kq = lane >> 4;
    { const int rpw = (nr + NWAVES - 1) / NWAVES, ra = r0 + rpw * F.wave, rb = min(r1, ra + rpw);
      f32x4 S[4] = {{0.f, 0.f, 0.f, 0.f}, {0.f, 0.f, 0.f, 0.f}, {0.f, 0.f, 0.f, 0.f}, {0.f, 0.f, 0.f, 0.f}}; int cnt[4] = {1, 1, 1, 1};
      for (int row = ra; row < rb; ++row) {
        int bidx, t, Lseq;
        if (row < NL) { bidx = row >> 11; t = row & 2047; Lseq = SEQ; } else { bidx = 8; t = (row - NL) & 255; Lseq = CTXL; }
        const int base = row - t; const float* xs = xrow_ptr(F, row);
        const float* s1 = modv + (bidx * 6 + 1) * 1024;
        const float rself = rinv_l[row - h0];
        f32x4 self[4];
#pragma unroll
        for (int j = 0; j < 4; ++j) self[j] = *(const f32x4*)(xs + 256 * j + 4 * lane);
        if (row == ra || t == 0) {
            S[0] = win_sum<2>(F, rinv_l, h0, base, t, Lseq, 4 * lane, cnt[0]);
            S[1] = win_sum<4>(F, rinv_l, h0, base, t, Lseq, 256 + 4 * lane, cnt[1]);
            S[2] = win_sum<8>(F, rinv_l, h0, base, t, Lseq, 512 + 4 * lane, cnt[2]);
            S[3] = win_sum<16>(F, rinv_l, h0, base, t, Lseq, 768 + 4 * lane, cnt[3]);
        } else {
            f32x4 va[4], vr[4]; float wa[4], wr_[4];
#pragma unroll
            for (int j = 0; j < 4; ++j) { const int hw = 1 << j;
                const int ta = t + hw - 1, tr = t - 1 - hw; const bool oka = ta < Lseq, okr = tr >= 0;
                const int rra = base + (oka ? ta : Lseq - 1), rrr = base + (okr ? tr : 0);
                va[j] = *(const f32x4*)(xrow_ptr(F, rra) + 256 * j + 4 * lane); vr[j] = *(const f32x4*)(xrow_ptr(F, rrr) + 256 * j + 4 * lane);
                wa[j] = oka ? rinv_l[rra - h0] : 0.f; wr_[j] = okr ? rinv_l[rrr - h0] : 0.f; cnt[j] += (oka ? 1 : 0) - (okr ? 1 : 0); }
#pragma unroll
            for (int j = 0; j < 4; ++j) S[j] += va[j] * wa[j] - vr[j] * wr_[j];
        }
#pragma unroll
        for (int j = 0; j < 4; ++j) { const int col = 256 * j + 4 * lane;
            const f32x4 gg = *(const f32x4*)(ng + col) * (*(const f32x4*)(s1 + col) + 1.0f);
            const f32x4 d = (S[j] * (1.0f / (float)cnt[j]) - self[j] * rself) * gg;
            u32x2 w; w.x = pk2(d.x, d.y); w.y = pk2(d.z, d.w);
            *(LAS u32x2*)(dt + j * DT_TILE + (row - r0) * DT_LD + 4 * lane) = w; } } }
    __syncthreads();
#pragma nounroll
    for (int g = 0; g < 4; ++g) {
        bf16x8 af[8][2];
        { const bf16_t* wa = Wp + (size_t)g * 256 * 256 + (size_t)(F.wave * 32 + n16) * 256 + kq * 8;
#pragma unroll
          for (int ks = 0; ks < 8; ++ks) { af[ks][0] = *(const bf16x8*)(wa + ks * 32); af[ks][1] = *(const bf16x8*)(wa + 16 * 256 + ks * 32); } }
        f32x4 acc[5][2];
#pragma unroll
        for (int tt = 0; tt < 5; ++tt) { acc[tt][0] = (f32x4){0.f, 0.f, 0.f, 0.f}; acc[tt][1] = acc[tt][0]; }
        const LAS bf16_t* db = dt + g * DT_TILE + n16 * DT_LD + kq * 8;
#pragma unroll
        for (int ks = 0; ks < 8; ++ks) {
#pragma unroll
            for (int tt = 0; tt < 5; ++tt) { const bf16x8 b = *(const LAS bf16x8*)(db + tt * 16 * DT_LD + ks * 32);
                acc[tt][0] = __builtin_amdgcn_mfma_f32_16x16x32_bf16(af[ks][0], b, acc[tt][0], 0, 0, 0); acc[tt][1] = __builtin_amdgcn_mfma_f32_16x16x32_bf16(af[ks][1], b, acc[tt][1], 0, 0, 0); } }
        f32x4 xin[5][2], g1v[5][2];
#pragma unroll
        for (int tt = 0; tt < 5; ++tt) { const int tok = min(tt * 16 + n16, nr - 1), row = r0 + tok, bidx = row < NL ? (row >> 11) : 8;
#pragma unroll
            for (int nt = 0; nt < 2; ++nt) { const int c = 256 * g + F.wave * 32 + nt * 16 + 4 * kq; xin[tt][nt] = *(const f32x4*)(xrow_ptr(F, row) + c); g1v[tt][nt] = *(const f32x4*)(modv + (bidx * 6 + 2) * 1024 + c); } }
#pragma unroll
        for (int nt = 0; nt < 2; ++nt) { const int c = 256 * g + F.wave * 32 + nt * 16 + 4 * kq; const f32x4 bv = *(const f32x4*)(pb + c), sv = *(const f32x4*)(ps + c);
#pragma unroll
            for (int tt = 0; tt < 5; ++tt) { const int tok = tt * 16 + n16;
                if (tok < nr) { const f32x4 x1 = xin[tt][nt] + (acc[tt][nt] + bv) * sv * g1v[tt][nt];
                    u32x2 w; w.x = pk2(x1.x, x1.y); w.y = pk2(x1.z, x1.w); *(u32x2*)(X1 + (size_t)(r0 + tok) * D + c) = w; } } }
    }
    VM_WAIT(); __syncthreads();
}

constexpr int RW_LD = 1032;
__device__ __forceinline__ void route_phase(Frame& F, const bf16_t* xin, int nrows, int layer, int cl) {
    const int rpb = (nrows + F.G - 1) / F.G, r0 = F.vcu * rpb, r1 = min(nrows, r0 + rpb), nr = r1 > r0 ? r1 - r0 : 0;
    const float* rwt = (const float*)(F.ws + WS_RWT) + (size_t)layer * 32 * 1024;
    LAS bf16_t* rwb = (LAS bf16_t*)F.lds;
    LAS float* lg = (LAS float*)(F.lds + 32 * RW_LD * 2);
    { f32x4 wv[16];
#pragma unroll
      for (int k = 0; k < 16; ++k) wv[k] = ((const f32x4*)rwt)[F.tid + k * NTHR];
#pragma unroll
      for (int k = 0; k < 16; ++k) { const int i = F.tid + k * NTHR, e = i >> 8, c = (i & 255) * 4; u32x2 p; p.x = pk2(wv[k].x, wv[k].y); p.y = pk2(wv[k].z, wv[k].w); *(LAS u32x2*)(rwb + e * RW_LD + c) = p; } }
    LAS int* lcnt = (LAS int*)(F.misc + M_LCNT); LAS int* lbase = (LAS int*)(F.misc + M_LBASE);
    if (F.tid < 32) lcnt[F.tid] = 0;
    const float* ng = F.in[7] + layer * 1024; const float* rb = F.in[19] + layer * 32;
    const float* modv = (const float*)(F.ws + WS_MODV) + (size_t)layer * 9 * 6144;
    unsigned char* H8 = F.ws + WS_H8;
    LAS bf16_t* ht = (LAS bf16_t*)(F.lds + 32 * RW_LD * 2 + 80 * 33 * 4);
    const int lane = F.lane;
    __syncthreads();
    for (int c0r = 0; c0r < nr; c0r += 32) {
        const int cend = min(c0r + 32, nr);
        for (int rl = c0r + F.wave; rl < cend; rl += 2 * NWAVES) {
            const int rlb = rl + NWAVES; const bool hasb = rlb < cend; const int row = r0 + rl, rowb = r0 + rlb, rb_ = hasb ? rowb : row;
            const u32x2* xa = (const u32x2*)(xin + (size_t)row * D) + lane; const u32x2* xb = (const u32x2*)(xin + (size_t)rb_ * D) + lane;
            f32x4 va[4], vb[4]; float sa = 0.f, sb = 0.f;
#pragma unroll
            for (int j = 0; j < 4; ++j) { const u32x2 wa = xa[64 * j], wb = xb[64 * j]; va[j] = (f32x4){bf_lo(wa.x), bf_hi(wa.x), bf_lo(wa.y), bf_hi(wa.y)}; vb[j] = (f32x4){bf_lo(wb.x), bf_hi(wb.x), bf_lo(wb.y), bf_hi(wb.y)}; }
#pragma unroll
            for (int j = 0; j < 4; ++j) { sa += (va[j].x * va[j].x + va[j].y * va[j].y) + (va[j].z * va[j].z + va[j].w * va[j].w); sb += (vb[j].x * vb[j].x + vb[j].y * vb[j].y) + (vb[j].z * vb[j].z + vb[j].w * vb[j].w); }
            const float ra = 1.0f / sqrtf(wave_sum(sa) * (1.0f / D) + EPS), rbv = 1.0f / sqrtf(wave_sum(sb) * (1.0f / D) + EPS);
            const int bia = row < NL ? (row >> 11) : 8, bib = rb_ < NL ? (rb_ >> 11) : 8;
#pragma unroll
            for (int j = 0; j < 4; ++j) { const int col = 256 * j + 4 * lane; const f32x4 g = *(const f32x4*)(ng + col);
                const f32x4 ha = va[j] * ra * g * (*(const f32x4*)(modv + (bia * 6 + 4) * 1024 + col) + 1.0f) + *(const f32x4*)(modv + (bia * 6 + 3) * 1024 + col);
                *(unsigned*)(H8 + (size_t)row * D + col) = pk_fp8x4(ha * 8.0f);
                u32x2 w; w.x = pk2(ha.x, ha.y); w.y = pk2(ha.z, ha.w); *(LAS u32x2*)(ht + (rl - c0r) * RW_LD + col) = w;
                if (hasb) { const f32x4 hb = vb[j] * rbv * g * (*(const f32x4*)(modv + (bib * 6 + 4) * 1024 + col) + 1.0f) + *(const f32x4*)(modv + (bib * 6 + 3) * 1024 + col);
                    *(unsigned*)(H8 + (size_t)rowb * D + col) = pk_fp8x4(hb * 8.0f);
                    u32x2 w2; w2.x = pk2(hb.x, hb.y); w2.y = pk2(hb.z, hb.w); *(LAS u32x2*)(ht + (rlb - c0r) * RW_LD + col) = w2; } }
        }
        LDS_WAIT(); asm volatile("" ::: "memory"); __builtin_amdgcn_s_barrier(); asm volatile("" ::: "memory");
        { const int tt_ = F.wave & 1, eh = (F.wave >> 1) & 1;
          if (F.wave < 4 && c0r + tt_ * 16 < nr) {
            const int n = lane & 15, kq = lane >> 4;
            const LAS bf16_t* hp = ht + (tt_ * 16 + n) * RW_LD + kq * 8; const LAS bf16_t* wp = rwb + (eh * 16 + n) * RW_LD + kq * 8;
            f32x4 ca = (f32x4){0.f, 0.f, 0.f, 0.f}, cb = ca;
#pragma unroll 8
            for (int ks = 0; ks < 32; ks += 2) {
                ca = __builtin_amdgcn_mfma_f32_16x16x32_bf16(*(const LAS bf16x8*)(wp + ks * 32), *(const LAS bf16x8*)(hp + ks * 32), ca, 0, 0, 0);
                cb = __builtin_amdgcn_mfma_f32_16x16x32_bf16(*(const LAS bf16x8*)(wp + (ks + 1) * 32), *(const LAS bf16x8*)(hp + (ks + 1) * 32), cb, 0, 0, 0); }
            LAS float* lr = lg + (c0r + tt_ * 16 + n) * 33 + eh * 16 + 4 * kq;
#pragma unroll
            for (int j = 0; j < 4; ++j) lr[j] = (ca[j] + cb[j]) + rb[eh * 16 + 4 * kq + j];
          } }
        LDS_WAIT(); asm volatile("" ::: "memory"); __builtin_amdgcn_s_barrier(); asm volatile("" ::: "memory");
    }
    int te[4] = {0, 0, 0, 0}, lp[4] = {0, 0, 0, 0}; float tg[4] = {0.f, 0.f, 0.f, 0.f};
    if (F.tid < nr) { const LAS float* l = lg + F.tid * 33; float tv[4] = {-3.0e38f, -3.0e38f, -3.0e38f, -3.0e38f};
#pragma unroll 4
        for (int e = 0; e < 32; ++e) { const float v = l[e];
            if (v > tv[3]) { if (v > tv[0]) { tv[3] = tv[2]; te[3] = te[2]; tv[2] = tv[1]; te[2] = te[1]; tv[1] = tv[0]; te[1] = te[0]; tv[0] = v; te[0] = e; }
                else if (v > tv[1]) { tv[3] = tv[2]; te[3] = te[2]; tv[2] = tv[1]; te[2] = te[1]; tv[1] = v; te[1] = e; }
                else if (v > tv[2]) { tv[3] = tv[2]; te[3] = te[2]; tv[2] = v; te[2] = e; }
                else { tv[3] = v; te[3] = e; } } }
        const float e1 = expf(tv[1] - tv[0]), e2 = expf(tv[2] - tv[0]), e3 = expf(tv[3] - tv[0]), inv = 1.0f / (1.0f + e1 + e2 + e3);
        tg[0] = inv; tg[1] = e1 * inv; tg[2] = e2 * inv; tg[3] = e3 * inv;
#pragma unroll
        for (int k = 0; k < 4; ++k) lp[k] = __hip_atomic_fetch_add(lcnt + te[k], 1, __ATOMIC_RELAXED, __HIP_MEMORY_SCOPE_WORKGROUP); }
    __syncthreads();
    if (F.tid < 32) { const int c = lcnt[F.tid]; lbase[F.tid] = c ? (int)__hip_atomic_fetch_add(F.ctl + CW_GCOUNT + (cl * 32 + F.tid) * 64, (unsigned)c, __ATOMIC_RELAXED, __HIP_MEMORY_SCOPE_AGENT) : 0; }
    __syncthreads();
    if (F.tid < nr) { const int row = r0 + F.tid; float* gate = (float*)(F.ws + WS_ROUTE + (size_t)NT * 16); int* slot_aid = (int*)(F.ws + WS_SLOTAID + (cl >= 2 ? 8 * MiB : 0)); int* slot_tok = (int*)(F.ws + WS_SLOTTOK + (cl >= 2 ? 8 * MiB : 0));
        gst16(gate + (size_t)row * 4, (f32x4)((f32x4){tg[0], tg[1], tg[2], tg[3]}));
#pragma unroll
        for (int k = 0; k < 4; ++k) { const size_t p = (size_t)te[k] * NT + lbase[te[k]] + lp[k]; slot_aid[p] = row * 4 + k; slot_tok[p] = row; } }
    __syncthreads();
}

__device__ __forceinline__ int moe_build(Frame& F, int layer, int ntn, bool gather, const float* bias_g) {
    LAS int* tstart = (LAS int*)(F.misc + M_TSTART); LAS int* gcnt = (LAS int*)(F.misc + M_GCNT); LAS int* tab = (LAS int*)(F.misc + M_TAB);
    __syncthreads();
    if (F.tid < 32) gcnt[F.tid] = (int)F.ctl[CW_GCOUNT + (layer * 32 + F.tid) * 64];
    __syncthreads();
    if (F.tid == 0) { int t = 0;
#pragma unroll
        for (int e = 0; e < 32; ++e) { tstart[e] = t; t += (gcnt[e] + 255) >> 8; } tstart[32] = t; }
    __syncthreads();
    if (F.tid < 16) {
        const int U = tstart[32] * ntn, L = F.tid * F.G + (int)blockIdx.x;
        if (L < U) { const int wgid = pg8::xcd_remap(L, U); int e = 0;
#pragma unroll
            for (int q = 1; q < 32; ++q) e += (tstart[q] * ntn <= wgid) ? 1 : 0;
            const int loc = wgid - tstart[e] * ntn, mt = loc / ntn, nv = gcnt[e] - mt * 256, n = F.tid;
            tab[8 * n] = tstart[e] + mt; tab[8 * n + 1] = loc % ntn; tab[8 * n + 2] = e; tab[8 * n + 3] = mt; tab[8 * n + 4] = nv < 256 ? nv : 256; }
        if (F.tid == 0) { const int cnt = U > (int)blockIdx.x ? (U - 1 - (int)blockIdx.x) / F.G + 1 : 0; tab[8 * 16] = cnt < 16 ? cnt : 16; } }
    __syncthreads();
    const int n = tab[8 * 16];
    LAS int* rowl = (LAS int*)(F.lds + TOK_OFF); LAS float* biasl = (LAS float*)(F.lds + BIAS_OFF);
    const int* src = (const int*)(F.ws + (gather ? WS_SLOTTOK : WS_SLOTAID));
    { int rv[5]; float bv[5];
#pragma unroll
      for (int k = 0; k < 5; ++k) { const int i = min(F.tid + k * NTHR, n * 256 - 1), u = i >> 8, r = i & 255, e = tab[8 * u + 2], mt = tab[8 * u + 3], nv = tab[8 * u + 4], pn = tab[8 * u + 1];
          rv[k] = src[(size_t)e * NT + mt * 256 + (r < nv ? r : 0)]; if (r >= nv) rv[k] = gather ? 0 : -1;
          bv[k] = gather ? bias_g[(size_t)e * 2048 + (r >> 7) * 1024 + pn * 128 + (r & 127)] : bias_g[(size_t)e * 1024 + pn * 256 + r]; }
#pragma unroll
      for (int k = 0; k < 5; ++k) { const int i = F.tid + k * NTHR; if (i < n * 256) { rowl[i] = rv[k]; biasl[i] = bv[k]; } } }
    __syncthreads();
    return n;
}

struct CombRow { f32x4 x[4]; u32x2 y[4][2]; f32x4 gt; };
__device__ __forceinline__ void comb_load(CombRow& r, const bf16_t* xi, const unsigned char* YS, const float* gate, int row, int lane) {
    const bf16_t* xp = xi + (size_t)row * D + 8 * lane;
    unpk8(*(const u32x4*)(xp), r.x[0], r.x[1]); unpk8(*(const u32x4*)(xp + 512), r.x[2], r.x[3]);
    r.gt = *(const f32x4*)(gate + (size_t)row * 4);
#pragma unroll
    for (int k = 0; k < 4; ++k) { const unsigned char* yp = YS + ((size_t)row * 4 + k) * D + 8 * lane; r.y[k][0] = *(const u32x2*)(yp); r.y[k][1] = *(const u32x2*)(yp + 512); }
}
template <int MODE> __device__ __forceinline__ void comb_finish(Frame& F, CombRow& r, void* xo_, int row, int layer, int lane) {
    const float* modv = (const float*)(F.ws + WS_MODV); bf16_t* H = (bf16_t*)(F.ws + WS_H);
    const int bidx = row < NL ? (row >> 11) : 8;
    const float* g2 = modv + ((size_t)layer * 9 + bidx) * 6144 + 5 * 1024;
    float ss = 0.f;
#pragma unroll
    for (int hh = 0; hh < 2; ++hh) { f32x4 y0 = (f32x4){0.f, 0.f, 0.f, 0.f}, y1 = y0;
#pragma unroll
        for (int k = 0; k < 4; ++k) { const u32x2 w = r.y[k][hh]; const float gk = r.gt[k] * (1.0f / 16.0f);
            const f32x2 a = __builtin_amdgcn_cvt_pk_f32_fp8((int)w.x, false), b = __builtin_amdgcn_cvt_pk_f32_fp8((int)w.x, true);
            const f32x2 c = __builtin_amdgcn_cvt_pk_f32_fp8((int)w.y, false), d = __builtin_amdgcn_cvt_pk_f32_fp8((int)w.y, true);
            y0.x += gk * a.x; y0.y += gk * a.y; y0.z += gk * b.x; y0.w += gk * b.y;
            y1.x += gk * c.x; y1.y += gk * c.y; y1.z += gk * d.x; y1.w += gk * d.y; }
        const int col = 512 * hh + 8 * lane;
        r.x[2 * hh] = r.x[2 * hh] + *(const f32x4*)(g2 + col) * y0; r.x[2 * hh + 1] = r.x[2 * hh + 1] + *(const f32x4*)(g2 + col + 4) * y1; }
#pragma unroll
    for (int i = 0; i < 4; ++i) ss += (r.x[i].x * r.x[i].x + r.x[i].y * r.x[i].y) + (r.x[i].z * r.x[i].z + r.x[i].w * r.x[i].w);
    const float rinv = 1.0f / sqrtf(wave_sum(ss) * (1.0f / D) + EPS);
    if (MODE == 0) {
        const float* ng = F.in[6] + 1024; const float* sh1 = modv + ((size_t)9 + bidx) * 6144; const float* s1 = sh1 + 1024;
#pragma unroll
        for (int hh = 0; hh < 2; ++hh) { const int col = 512 * hh + 8 * lane;
            *(u32x4*)((bf16_t*)xo_ + (size_t)row * D + col) = pk8(r.x[2 * hh], r.x[2 * hh + 1]);
            const f32x4 h0 = r.x[2 * hh] * rinv * *(const f32x4*)(ng + col) * (*(const f32x4*)(s1 + col) + 1.0f) + *(const f32x4*)(sh1 + col);
            const f32x4 h1 = r.x[2 * hh + 1] * rinv * *(const f32x4*)(ng + col + 4) * (*(const f32x4*)(s1 + col + 4) + 1.0f) + *(const f32x4*)(sh1 + col + 4);
            *(u32x2*)(F.ws + WS_H8 + (size_t)row * D + col) = pk_fp8x8(h0, h1, 8.0f); }
    } else {
        const float* fg = F.in[24];
#pragma unroll
        for (int hh = 0; hh < 2; ++hh) { const int col = 512 * hh + 8 * lane; float* xop = (float*)xo_ + (size_t)row * D + col;
            gst16(xop, (f32x4)(r.x[2 * hh] * rinv * *(const f32x4*)(fg + col))); gst16(xop + 4, (f32x4)(r.x[2 * hh + 1] * rinv * *(const f32x4*)(fg + col + 4))); }
    }
}
template <int MODE> __device__ __forceinline__ void combine_phase(Frame& F, const bf16_t* xi, void* xo, int nrows, int layer) {
    const int rpb = (nrows + F.G - 1) / F.G, r0 = F.vcu * rpb, r1 = min(nrows, r0 + rpb);
    const float* gate = (const float*)(F.ws + WS_ROUTE + (size_t)NT * 16); const unsigned char* YS = F.ws + WS_YS;
    const int lane = F.lane;
    for (int row = r0 + F.wave; row < r1; row += 2 * NWAVES) {
        const int rowb = row + NWAVES; const bool hasb = rowb < r1;
        CombRow ra, rb; comb_load(ra, xi, YS, gate, row, lane); comb_load(rb, xi, YS, gate, hasb ? rowb : row, lane);
        comb_finish<MODE>(F, ra, xo, row, layer, lane);
        if (hasb) comb_finish<MODE>(F, rb, xo, rowb, layer, lane);
    }
}

__device__ __forceinline__ int proj2_build(Frame& F) {
    LAS int* tab = (LAS int*)(F.misc + M_TAB);
    __syncthreads();
    if (F.tid == 0) { const int c = (int)blockIdx.x; int n = 0;
        const unsigned long long aK = (unsigned long long)(F.ws + WS_H8), aQ = (unsigned long long)(F.ws + WS_QA), aV = (unsigned long long)(F.ws + WS_CKV);
        const unsigned long long bK = (unsigned long long)(F.ws + WS_WP1) + (unsigned long long)768 * 1024, bQ = (unsigned long long)(F.ws + WS_WUQ), bV = (unsigned long long)(F.ws + WS_WUKV);
#define P2_PUT(ty_, pm_, pn_, nt_, ab_, bb_) do { const unsigned long long tile_ = (unsigned long long)256 * 128 * (nt_); const unsigned long long pa_ = (ab_) + (pm_) * tile_, pb_ = (bb_) + (pn_) * tile_; \
        tab[8 * n] = (pm_); tab[8 * n + 1] = (pn_); tab[8 * n + 2] = (ty_); tab[8 * n + 3] = (nt_); tab[8 * n + 4] = (int)(unsigned)pa_; tab[8 * n + 5] = (int)(unsigned)(pa_ >> 32); \
        tab[8 * n + 6] = (int)(unsigned)pb_; tab[8 * n + 7] = (int)(unsigned)(pb_ >> 32); ++n; } while (0)
#define P2_KPE(i_) P2_PUT(0, (i_), 0, 8, aK, bK)
#define P2_UQ(i_)  P2_PUT(1, (i_) / 6, (i_) % 6, 4, aQ, bQ)
#define P2_UKV(i_) P2_PUT(2, (i_) / 8, (i_) % 8, 2, aV, bV)
        if (c < 16) { P2_KPE(c); P2_UQ(368 + c); }
        else if (c < 72) { P2_KPE(c); P2_UKV(2 * (c - 16)); P2_UKV(2 * (c - 16) + 1); }
        else { P2_UQ(2 * (c - 72)); P2_UQ(2 * (c - 72) + 1); P2_UKV(112 + 2 * (c - 72)); P2_UKV(112 + 2 * (c - 72) + 1); }
        if (c >= 16 && c < 112) P2_UKV(480 + c - 16);
#undef P2_KPE
#undef P2_PUT
#undef P2_UQ
#undef P2_UKV
        tab[8 * 16] = n; }
    __syncthreads();
    const int n = tab[8 * 16];
    { LAS float* rinvl = (LAS float*)(F.lds + TOK_OFF); const float* ssq = (const float*)(F.ws + WS_SSQ);
      float pv[3][8]; int tyv[3];
#pragma unroll
      for (int k = 0; k < 3; ++k) { const int i = min(F.tid + k * NTHR, n * 256 - 1), u = i >> 8, r = i & 255, row = tab[8 * u] * 256 + r; tyv[k] = tab[8 * u + 2];
#pragma unroll
          for (int p = 0; p < 8; ++p) { const int pp = tyv[k] == 1 ? p : 8 + (p & 3); pv[k][p] = ssq[(size_t)pp * NT + row]; } }
#pragma unroll
      for (int k = 0; k < 3; ++k) { const int i = F.tid + k * NTHR;
          if (i < n * 256) {
              if (tyv[k] == 1) { float sm = 0.f;
#pragma unroll
                  for (int p = 0; p < 8; ++p) sm += pv[k][p];
                  rinvl[i] = (1.0f / 512.0f) / sqrtf(sm * (1.0f / QLORA) + EPS); }
              else { const float sm = (pv[k][0] + pv[k][1]) + (pv[k][2] + pv[k][3]);
                  rinvl[i] = (1.0f / 512.0f) / sqrtf(sm * (1.0f / KVLORA) + EPS); } } }
      __syncthreads(); }
    return n;
}

constexpr int NPHASE = 15;
__global__ void __launch_bounds__(NTHR, 2) trunk_fwd(Args args) {
    extern __shared__ __attribute__((aligned(16))) unsigned char lds_raw[];
    Frame F;
    F.lds = (LAS unsigned char*)lds_raw; F.misc = F.lds + MISC_OFF;
    F.tid = threadIdx.x; F.lane = F.tid & 63; F.wave = __builtin_amdgcn_readfirstlane(F.tid >> 6);
    F.G = gridDim.x; { const int bx = blockIdx.x; F.vcu = (F.G % 8 == 0) ? (bx % 8) * (F.G / 8) + bx / 8 : bx; }
    F.ws = args.ws; F.ctl = (unsigned*)(args.ws + WS_CTL); F.out = args.out;
#pragma unroll
    for (int i = 0; i < 25; ++i) F.in[i] = args.in[i];
    if (F.tid < 4) ((LAS unsigned*)(F.misc + M_BAR))[F.tid] = 0u;
    __syncthreads();
    XcdBarrier bar; bar.bar = F.ctl + CW_BAR; bar.x = 0; bar.st = nullptr;
#if !MK_PER_PHASE
    bar = xcd_barrier_post(F.ctl + CW_BAR, (volatile LAS unsigned*)(F.misc + M_BAR));
#endif
    const int lo = args.ph_lo, hi = args.ph_hi;
#ifndef PH_MASK
#define PH_MASK 0xFFFFFFFFu
#endif
#define IN(k) (((PH_MASK >> (k)) & 1u) && lo <= (k) && (k) < hi && ((F.lane = opq(lane_id())), (F.tid = F.wave * 64 + F.lane), true))
#if MK_PER_PHASE
#define SEAM(k) do { } while (0)
#else
#ifndef PROBE_XBAR
#define PROBE_XBAR 0
#endif
#define SEAM(k) do { if (IN((k) + 1)) { for (int xb_ = 0; xb_ <= PROBE_XBAR; ++xb_) xcd_barrier(bar, F.wave == 0 && lane_id() == 0); } } while (0)
#endif
    bf16_t* X1 = (bf16_t*)(F.ws + WS_X1); bf16_t* X2 = (bf16_t*)(F.ws + WS_X2); bf16_t* X3 = (bf16_t*)(F.ws + WS_X3);
    const float* modv = (const float*)(F.ws + WS_MODV);
    const f32x2* rope = (const f32x2*)(F.ws + WS_ROPE);
    float* ssq = (float*)(F.ws + WS_SSQ);
    bf16_t* Hb = (bf16_t*)(F.ws + WS_H);

    if (IN(0)) { REPEAT(0) { p0_prologue(F); } SEAM(0); }
    if (IN(1)) { const int cslot = F.vcu % 3;
        if (cslot == 0) { REPEAT(16) { convert_experts(F, 0, 0, I_GU8L); __syncthreads(); } }
        pool_block(F, X1);
        if (cslot == 1) { REPEAT(16) { convert_experts(F, 0, 0, I_GU8L); __syncthreads(); } }
        REPEAT(2) { route_phase(F, X1, NT, 0, (rep_ == (int)((REP_MASK >> 2) & 1u)) ? 0 : 2); }
        if (cslot == 2) { REPEAT(16) { __syncthreads(); convert_experts(F, 0, 0, I_GU8L); } }
        SEAM(3); }
    if (IN(4)) {
        REPEAT(4) {
        const bool conv_first = (F.vcu & 1) == 0;
        if (conv_first && rep_ == 0) { convert_experts(F, 0, I_GU8L, I_GU8L + I_DN8L); }
        const int n = moe_build(F, 0, 8, true, F.in[21]);
        pg8::MoeSched S{(const LAS int*)(F.misc + M_TAB), n, (const char*)(F.ws + WS_H8), (const char*)(F.ws + WS_WGU), (size_t)0, (size_t)2048 * 1024, (size_t)256 * 1024};
        EpiGu E{F.ws + WS_ACT, (const LAS float*)(F.lds + BIAS_OFF)};
        pg8::gemm_phase<true, true, false>(F.lds, pg8::GemmP{1024, 1024, 8}, S, E, F.wave, PROBE_NOEPI && rep_ > 0);
        if (!conv_first && rep_ == 0) { __syncthreads(); convert_experts(F, 0, I_GU8L, I_GU8L + I_DN8L); }
        }
        SEAM(4);
    }
    if (IN(5)) {
        REPEAT(5) {
        const int n = moe_build(F, 0, 4, false, F.in[23]);
        pg8::MoeSched S{(const LAS int*)(F.misc + M_TAB), n, (const char*)(F.ws + WS_ACT), (const char*)(F.ws + WS_WDN), (size_t)256 * 1024, (size_t)1024 * 1024, (size_t)256 * 1024};
        EpiDown E{F.ws + WS_YS, (const LAS float*)(F.lds + BIAS_OFF), (const LAS int*)(F.lds + TOK_OFF)};
        pg8::gemm_phase<true, false, false>(F.lds, pg8::GemmP{1024, 1024, 8}, S, E, F.wave, PROBE_NOEPI && rep_ > 0);
        }
        SEAM(5);
    }
    if (IN(6)) { REPEAT(6) { combine_phase<0>(F, X1, X2, NT, 0); } SEAM(6); }
    if (IN(7)) {
        REPEAT(7) {
        pg8::PlainSched S{NT / 256, 3, (NT / 256) * 3, F.G, (int)blockIdx.x, (const char*)(F.ws + WS_H8), (const char*)(F.ws + WS_WP1), (size_t)256 * 1024, 0, (size_t)256 * 1024};
        EpiP1 E{F.ws + WS_QA, F.ws + WS_CKV, ssq};
        pg8::gemm_phase<true, false, false>(F.lds, pg8::GemmP{1024, 1024, 8}, S, E, F.wave, PROBE_NOEPI && rep_ > 0);
        }
        SEAM(7);
    }
    if (IN(8)) {
        REPEAT(8) {
        const int n = proj2_build(F);
        Proj2Sched S{(const LAS int*)(F.misc + M_TAB), n};
        EpiProj2 E{EpiKpe{F.ws + WS_K, rope}, EpiUq{F.ws + WS_Q, (const LAS float*)(F.lds + TOK_OFF), rope}, EpiUkv{F.ws + WS_K, F.ws + WS_V, (const LAS float*)(F.lds + TOK_OFF)}};
        pg8::gemm_phase<true, false, true>(F.lds, pg8::GemmP{0, 0, 0}, S, E, F.wave, PROBE_NOEPI && rep_ > 0);
        }
        SEAM(8);
    }
    if (IN(9)) {
        REPEAT(9) {
        const unsigned char* Q = F.ws + WS_Q; const unsigned char* K = F.ws + WS_K; const unsigned char* V = F.ws + WS_V; unsigned char* O = F.ws + WS_ATT;
        const int cslot = (F.vcu + 1) % 3;
        int k = 0;
        for (int u = F.vcu; u < NB * NH * (SEQ / 256); u += F.G, ++k) { const int qb = u & 7, bh = u >> 3, b = bh >> 3, h = bh & 7;
            __syncthreads();
            if (k == cslot && rep_ == 0) { convert_experts(F, 1, 0, I_GU8L + I_DN8L); __syncthreads(); }
            att::attn_unit<0>(Q + ((size_t)bh * SEQ + qb * 256) * DQK, K + (size_t)bh * SKV * DQK, V + (size_t)bh * SKV * DV, O + ((size_t)b * SEQ + qb * 256) * 1024 + h * 128, F.lds, F.wave); }
        if (cslot == 2 && rep_ == 0) { __syncthreads(); convert_experts(F, 1, 0, I_GU8L + I_DN8L); }
        }
        SEAM(9);
    }
    if (IN(10)) {
        REPEAT(10) {
        pg8::PlainSched S{NL / 256, 4, (NL / 256) * 4, F.G, (int)blockIdx.x, (const char*)(F.ws + WS_ATT), (const char*)(F.ws + WS_WO), (size_t)256 * 1024, 0, (size_t)256 * 1024};
        EpiWo E{X2, X3, modv + 9 * 6144};
        pg8::gemm_phase<true, false, false>(F.lds, pg8::GemmP{1024, 1024, 8}, S, E, F.wave, PROBE_NOEPI && rep_ > 0);
        }
        SEAM(10);
    }
    if (PROBE_ATT != 0 && IN(11)) {
        const unsigned char* Q = F.ws + WS_Q; const unsigned char* K = F.ws + WS_K; const unsigned char* V = F.ws + WS_V; unsigned char* O = F.ws + WS_ATT;
        for (int u = F.vcu; u < NB * NH * (SEQ / 256); u += F.G) { const int qb = u & 7, bh = u >> 3, b = bh >> 3, h = bh & 7;
            __syncthreads();
            att::attn_unit<PROBE_ATT>(Q + ((size_t)bh * SEQ + qb * 256) * DQK, K + (size_t)bh * SKV * DQK, V + (size_t)bh * SKV * DV, O + ((size_t)b * SEQ + qb * 256) * 1024 + h * 128, F.lds, F.wave); }
        __syncthreads(); }
    if (IN(11)) { REPEAT(11) { route_phase(F, X3, NL, 1, (rep_ == (int)((REP_MASK >> 11) & 1u)) ? 1 : 3); } SEAM(11); }
    if (IN(12)) {
        REPEAT(12) {
        const int n = moe_build(F, 1, 8, true, F.in[21] + 32 * 2048);
        pg8::MoeSched S{(const LAS int*)(F.misc + M_TAB), n, (const char*)(F.ws + WS_H8), (const char*)(F.ws + WS_WGU) + (size_t)32 * 2048 * 1024, (size_t)0, (size_t)2048 * 1024, (size_t)256 * 1024};
        EpiGu E{F.ws + WS_ACT, (const LAS float*)(F.lds + BIAS_OFF)};
        pg8::gemm_phase<true, true, false>(F.lds, pg8::GemmP{1024, 1024, 8}, S, E, F.wave, PROBE_NOEPI && rep_ > 0);
        }
        SEAM(12);
    }
    if (IN(13)) {
        REPEAT(13) {
        const int n = moe_build(F, 1, 4, false, F.in[23] + 32 * 1024);
        pg8::MoeSched S{(const LAS int*)(F.misc + M_TAB), n, (const char*)(F.ws + WS_ACT), (const char*)(F.ws + WS_WDN) + (size_t)32 * 1024 * 1024, (size_t)256 * 1024, (size_t)1024 * 1024, (size_t)256 * 1024};
        EpiDown E{F.ws + WS_YS, (const LAS float*)(F.lds + BIAS_OFF), (const LAS int*)(F.lds + TOK_OFF)};
        pg8::gemm_phase<true, false, false>(F.lds, pg8::GemmP{1024, 1024, 8}, S, E, F.wave, PROBE_NOEPI && rep_ > 0);
        }
        SEAM(13);
    }
    if (IN(14)) { REPEAT(14) { combine_phase<1>(F, X3, F.out, NL, 1); } }
#undef IN
#undef SEAM
}

extern "C" void kernel_launch(void* const* d_in, const int* in_sizes, int n_in, void* d_out, int out_size, void* d_ws, size_t ws_size, hipStream_t stream) {
    static int ready = 0;
    if (ready == 0) {
        if (n_in != 25 || out_size != NL * D || ws_size < WS_END) { fprintf(stderr, "kernel_launch: unexpected shapes: n_in %d out %d ws %zu (need >= %zu)\n", n_in, out_size, ws_size, (size_t)WS_END); ready = -1; return; }
        if (hipFuncSetAttribute((const void*)trunk_fwd, hipFuncAttributeMaxDynamicSharedMemorySize, LDS_BYTES) != hipSuccess) { fprintf(stderr, "kernel_launch: hipFuncSetAttribute failed\n"); ready = -1; return; }
        int per_cu = 0;
        if (hipOccupancyMaxActiveBlocksPerMultiprocessor(&per_cu, (const void*)trunk_fwd, NTHR, LDS_BYTES) != hipSuccess || per_cu < 1)
            fprintf(stderr, "kernel_launch: note: occupancy query reports %d workgroups per CU\n", per_cu);
        (void)hipGetLastError();
        ready = 1;
    }
    if (ready < 0) return;
    (void)hipMemsetAsync((char*)d_ws + WS_CTL, 0, CTL_ZERO_BYTES, stream);
    Args a{};
    for (int i = 0; i < 25; ++i) a.in[i] = (const float*)d_in[i];
    a.out = (float*)d_out; a.ws = (unsigned char*)d_ws;
#if MK_PER_PHASE
    for (int p = 0; p < NPHASE; ++p) { a.ph_lo = p; a.ph_hi = p + 1; hipLaunchKernelGGL(trunk_fwd, dim3(GRID), dim3(NTHR), LDS_BYTES, stream, a); }
#else
    a.ph_lo = 0; a.ph_hi = NPHASE; hipLaunchKernelGGL(trunk_fwd, dim3(GRID), dim3(NTHR), LDS_BYTES, stream, a);
#endif
    const hipError_t le = hipPeekAtLastError();
    if (le != hipSuccess) fprintf(stderr, "kernel_launch: launch failed: %s\n", hipGetErrorName(le));
}
```
